# Optimizing an MI355X kernel written in HIP

```python
import math
import jax
import jax.numpy as jnp
from jax import lax
import numpy as np

D_MODEL = 1024
BATCH = 4
SEQ = 4096
DEPTH = 1

N_META = 16
GLA_HEADS = 4
GLA_DK = 128
GLA_DV = 256
GLA_QK = GLA_HEADS * GLA_DK
GLA_VW = GLA_HEADS * GLA_DV
GLA_GATE_RANK = 16
GLA_GATE_TAU = 16.0
GLA_CHUNK = 64
MLA_HEADS = 16
MLA_Q_RANK = 384
MLA_KV_RANK = 256
MLA_NOPE = 64
MLA_ROPE = 32
MLA_DV = 64
MLA_QDIM = MLA_NOPE + MLA_ROPE
MLA_VW = MLA_HEADS * MLA_DV
ROPE_BASE = 10000.0
Q_BLOCK = 128
N_GROUPS = 4
EXPERTS_PER_GROUP = 8
EXPERT_FF = 256
TOP_K = 2
ALPHA = (2.0 * DEPTH) ** 0.25
BETA = (8.0 * DEPTH) ** -0.25
LN_EPS = 1e-5
RMS_EPS = 1e-6
IN_SIZES = (GLA_QK, GLA_QK, GLA_VW, GLA_VW, GLA_GATE_RANK, MLA_Q_RANK, MLA_KV_RANK, MLA_ROPE, D_MODEL, D_MODEL)
IN_WIDTH = sum(IN_SIZES)
IN_OFFSETS = tuple(int(o) for o in np.cumsum(IN_SIZES)[:-1])

kernel_name = "hybrid_gla_mla_hmoe_deepnorm_meta"


def layer_norm(x, g, b):
    xf = x.astype(jnp.float32)
    mu = jnp.mean(xf, axis=-1, keepdims=True)
    var = jnp.mean(jnp.square(xf - mu), axis=-1, keepdims=True)
    return ((xf - mu) * lax.rsqrt(var + LN_EPS) * g.astype(jnp.float32) + b.astype(jnp.float32)).astype(x.dtype)


def rms_norm(x, g):
    xf = x.astype(jnp.float32)
    ms = jnp.mean(jnp.square(xf), axis=-1, keepdims=True)
    return (xf * lax.rsqrt(ms + RMS_EPS) * g.astype(jnp.float32)).astype(x.dtype)


def apply_rope(x, cos, sin):
    half = x.shape[-1] // 2
    x1, x2 = x[..., :half], x[..., half:]
    cos = cos.astype(x.dtype)
    sin = sin.astype(x.dtype)
    return jnp.concatenate([x1 * cos - x2 * sin, x1 * sin + x2 * cos], axis=-1)


def gla_mixer(q, k, v, log_a, r, norm_g):
    B, L, _ = q.shape
    pad = GLA_CHUNK - N_META
    padw = ((0, 0), (pad, 0), (0, 0))
    q, k, v, log_a = (jnp.pad(t, padw) for t in (q, k, v, log_a))
    Lp = L + pad
    n = Lp // GLA_CHUNK

    def to_chunks(t, d):
        return t.reshape(B, n, GLA_CHUNK, GLA_HEADS, d).transpose(0, 3, 1, 2, 4)

    qc = to_chunks(q, GLA_DK).astype(jnp.float32) * (GLA_DK ** -0.5)
    kc = to_chunks(k, GLA_DK).astype(jnp.float32)
    vc = to_chunks(v, GLA_DV).astype(jnp.float32)
    bc = jnp.cumsum(to_chunks(log_a, GLA_DK).astype(jnp.float32), axis=3)
    b_last = bc[:, :, :, -1:, :]
    q_t = qc * jnp.exp(bc)
    k_t = kc * jnp.exp(-bc)
    k_end = kc * jnp.exp(b_last - bc)
    causal = jnp.tril(jnp.ones((GLA_CHUNK, GLA_CHUNK), dtype=bool))
    att = jnp.einsum('bhncd,bhnsd->bhncs', q_t, k_t)
    att = jnp.where(causal, att, 0.0)
    o_intra = jnp.einsum('bhncs,bhnsv->bhncv', att, vc)
    upd = jnp.einsum('bhncd,bhncv->nbhdv', k_end, vc)
    dec = jnp.exp(b_last[:, :, :, 0, :]).transpose(2, 0, 1, 3)

    def step(state, inp):
        u, d = inp
        return d[..., None] * state + u, state

    s0 = jnp.zeros((B, GLA_HEADS, GLA_DK, GLA_DV), dtype=upd.dtype)
    _, s_before = lax.scan(step, s0, (upd, dec))
    o_inter = jnp.einsum('bhncd,nbhdv->bhncv', q_t, s_before)
    o = (o_intra + o_inter).transpose(0, 2, 3, 1, 4).reshape(B, Lp, GLA_HEADS, GLA_DV)[:, pad:]
    o = rms_norm(o, norm_g) * jax.nn.silu(r.reshape(B, L, GLA_HEADS, GLA_DV).astype(jnp.float32))
    return o.reshape(B, L, GLA_VW).astype(r.dtype)


def mla_mixer(c_q, c_kv, k_r, q_norm_g, w_uq, kv_norm_g, w_uk, w_uv, cos, sin):
    B, L, _ = c_q.shape
    q = (rms_norm(c_q, q_norm_g) @ w_uq).reshape(B, L, MLA_HEADS, MLA_QDIM)
    q_nope = q[..., :MLA_NOPE]
    q_rope = apply_rope(q[..., MLA_NOPE:], cos[:, None, :], sin[:, None, :])
    ckv = rms_norm(c_kv, kv_norm_g)
    k_nope = (ckv @ w_uk).reshape(B, L, MLA_HEADS, MLA_NOPE)
    v = (ckv @ w_uv).reshape(B, L, MLA_HEADS, MLA_DV)
    k_rope = apply_rope(k_r, cos, sin)
    nb = -(-L // Q_BLOCK)
    Lq = nb * Q_BLOCK
    padw = ((0, 0), (0, Lq - L), (0, 0), (0, 0))

    def to_blocks(t):
        return jnp.pad(t, padw).reshape(B, nb, Q_BLOCK, MLA_HEADS, t.shape[-1]).transpose(1, 0, 2, 3, 4)

    qn_b = to_blocks(q_nope)
    qr_b = to_blocks(q_rope)
    qpos_b = jnp.arange(Lq, dtype=jnp.int32).reshape(nb, Q_BLOCK)
    kpos = jnp.arange(L, dtype=jnp.int32)
    scale = MLA_QDIM ** -0.5

    def attend(args):
        qn, qr, qpos = args
        s = jnp.einsum('bqhd,bkhd->bhqk', qn, k_nope) + jnp.einsum('bqhd,bkd->bhqk', qr, k_rope)
        s = s.astype(jnp.float32) * scale
        s = jnp.where(qpos[:, None] >= kpos[None, :], s, jnp.finfo(jnp.float32).min)
        p = jax.nn.softmax(s, axis=-1).astype(v.dtype)
        return jnp.einsum('bhqk,bkhd->bqhd', p, v)

    o = lax.map(attend, (qn_b, qr_b, qpos_b))
    o = o.transpose(1, 0, 2, 3, 4).reshape(B, Lq, MLA_HEADS, MLA_DV)[:, :L]
    return o.reshape(B, L, MLA_VW)


def moe_ffn(h, w_rg, b_rg, w_re, b_re, w_gate, w_up, w_down):
    B, L, D = h.shape
    t = h.reshape(B * L, D)
    p_group = jax.nn.softmax((t @ w_rg + b_rg).astype(jnp.float32), axis=-1)
    g_idx = jnp.argmax(p_group, axis=-1)
    p_g = jnp.max(p_group, axis=-1)
    e_logits = (t @ w_re + b_re).astype(jnp.float32).reshape(-1, N_GROUPS, EXPERTS_PER_GROUP)
    e_sel = jnp.take_along_axis(e_logits, g_idx[:, None, None], axis=1)[:, 0]
    top_v, top_i = lax.top_k(e_sel, TOP_K)
    top_p = jax.nn.softmax(top_v, axis=-1)
    w_e = jnp.einsum('nk,nke->ne', top_p, jax.nn.one_hot(top_i, EXPERTS_PER_GROUP, dtype=jnp.float32))
    combine = (p_g[:, None, None] * jax.nn.one_hot(g_idx, N_GROUPS, dtype=jnp.float32)[:, :, None]
               * w_e[:, None, :]).astype(h.dtype)
    y = jnp.zeros_like(t)
    for grp in range(N_GROUPS):
        a = jnp.einsum('nd,edf->nef', t, w_gate[grp])
        u = jnp.einsum('nd,edf->nef', t, w_up[grp])
        hid = jax.nn.silu(a) * u * combine[:, grp, :, None]
        y = y + jnp.einsum('nef,efd->nd', hid, w_down[grp])
    return y.reshape(B, L, D)


def setup_inputs(seed: int = 0) -> dict:
    key = jax.random.key(seed)
    ks = jax.random.split(key, 32)
    f32 = jnp.float32
    nrm = lambda k, shape, s: jax.random.normal(k, shape, dtype=f32) * s
    gain = lambda k, shape: 1.0 + 0.02 * jax.random.normal(k, shape, dtype=f32)
    G, E, F, D = N_GROUPS, EXPERTS_PER_GROUP, EXPERT_FF, D_MODEL
    col_scale = jnp.ones((IN_WIDTH,), f32).at[2 * GLA_QK:2 * GLA_QK + GLA_VW].set(BETA)
    return {
        "x": nrm(ks[0], (BATCH, SEQ, D), 1.0),
        "meta_tokens": nrm(ks[1], (N_META, D), 1.0),
        "ln_emb_g": gain(ks[2], (D,)),
        "ln_emb_b": nrm(ks[3], (D,), 0.02),
        "w_in": nrm(ks[4], (DEPTH, D, IN_WIDTH), D ** -0.5) * col_scale,
        "gla_gate_w2": nrm(ks[5], (DEPTH, GLA_GATE_RANK, GLA_QK), GLA_GATE_RANK ** -0.5),
        "gla_gate_b": nrm(ks[6], (DEPTH, GLA_QK), 0.02),
        "gla_norm_g": gain(ks[7], (DEPTH, GLA_DV)),
        "mla_q_norm_g": gain(ks[8], (DEPTH, MLA_Q_RANK)),
        "mla_w_uq": nrm(ks[9], (DEPTH, MLA_Q_RANK, MLA_HEADS * MLA_QDIM), MLA_Q_RANK ** -0.5),
        "mla_kv_norm_g": gain(ks[10], (DEPTH, MLA_KV_RANK)),
        "mla_w_uk": nrm(ks[11], (DEPTH, MLA_KV_RANK, MLA_HEADS * MLA_NOPE), MLA_KV_RANK ** -0.5),
        "mla_w_uv": nrm(ks[12], (DEPTH, MLA_KV_RANK, MLA_VW), MLA_KV_RANK ** -0.5 * BETA),
        "w_branch_gla": nrm(ks[13], (DEPTH, GLA_VW, D), GLA_VW ** -0.5 * BETA),
        "w_branch_mla": nrm(ks[14], (DEPTH, MLA_VW, D), MLA_VW ** -0.5 * BETA),
        "w_out": nrm(ks[15], (DEPTH, D, D), D ** -0.5 * BETA),
        "ln_mix_g": gain(ks[16], (DEPTH, D)),
        "ln_mix_b": nrm(ks[17], (DEPTH, D), 0.02),
        "router_group_w": nrm(ks[18], (DEPTH, D, G), D ** -0.5),
        "router_group_b": nrm(ks[19], (DEPTH, G), 0.01),
        "router_expert_w": nrm(ks[20], (DEPTH, D, G * E), D ** -0.5),
        "router_expert_b": nrm(ks[21], (DEPTH, G * E), 0.01),
        "expert_w_gate": nrm(ks[22], (DEPTH, G, E, D, F), D ** -0.5),
        "expert_w_up": nrm(ks[23], (DEPTH, G, E, D, F), D ** -0.5 * BETA),
        "expert_w_down": nrm(ks[24], (DEPTH, G, E, F, D), F ** -0.5 * BETA),
        "ln_ffn_g": gain(ks[25], (DEPTH, D)),
        "ln_ffn_b": nrm(ks[26], (DEPTH, D), 0.02),
    }


def reference(x, meta_tokens, ln_emb_g, ln_emb_b, w_in, gla_gate_w2, gla_gate_b, gla_norm_g,
              mla_q_norm_g, mla_w_uq, mla_kv_norm_g, mla_w_uk, mla_w_uv, w_branch_gla, w_branch_mla,
              w_out, ln_mix_g, ln_mix_b, router_group_w, router_group_b, router_expert_w,
              router_expert_b, expert_w_gate, expert_w_up, expert_w_down, ln_ffn_g, ln_ffn_b):
    B = x.shape[0]
    meta = jnp.broadcast_to(meta_tokens[None].astype(x.dtype), (B, N_META, x.shape[-1]))
    s = layer_norm(jnp.concatenate([meta, x], axis=1), ln_emb_g, ln_emb_b)
    L = s.shape[1]
    pos = jnp.arange(L, dtype=jnp.float32)
    inv_freq = ROPE_BASE ** (-jnp.arange(0, MLA_ROPE, 2, dtype=jnp.float32) / MLA_ROPE)
    ang = pos[:, None] * inv_freq[None, :]
    cos, sin = jnp.cos(ang), jnp.sin(ang)
    for l in range(DEPTH):
        proj = s @ w_in[l]
        (q_g, k_g, v_g, r_g, a_lr, c_q, c_kv, k_r, gate_a, gate_b) = jnp.split(proj, IN_OFFSETS, axis=-1)
        log_a = jax.nn.log_sigmoid((a_lr @ gla_gate_w2[l] + gla_gate_b[l]).astype(jnp.float32)) / GLA_GATE_TAU
        o_gla = gla_mixer(q_g, k_g, v_g, log_a, r_g, gla_norm_g[l])
        o_mla = mla_mixer(c_q, c_kv, k_r, mla_q_norm_g[l], mla_w_uq[l], mla_kv_norm_g[l],
                          mla_w_uk[l], mla_w_uv[l], cos, sin)
        merged = (jax.nn.sigmoid(gate_a) * (o_gla @ w_branch_gla[l])
                  + jax.nn.sigmoid(gate_b) * (o_mla @ w_branch_mla[l]))
        s = layer_norm(ALPHA * s + merged @ w_out[l], ln_mix_g[l], ln_mix_b[l])
        ffn = moe_ffn(s, router_group_w[l], router_group_b[l], router_expert_w[l], router_expert_b[l],
                      expert_w_gate[l], expert_w_up[l], expert_w_down[l])
        s = layer_norm(ALPHA * s + ffn, ln_ffn_g[l], ln_ffn_b[l])
    return s[:, N_META:]
```

```cpp
#include <hip/hip_runtime.h>
#include <cstdio>
#include <cstdint>

#define GAS __attribute__((address_space(1)))
#define LAS __attribute__((address_space(3)))
typedef unsigned short bf16;
typedef short bf16x8 __attribute__((ext_vector_type(8)));
typedef short s16x4 __attribute__((ext_vector_type(4)));
typedef float f32x2 __attribute__((ext_vector_type(2)));
typedef float f32x4 __attribute__((ext_vector_type(4)));
typedef float f32x16 __attribute__((ext_vector_type(16)));
typedef unsigned u32x2 __attribute__((ext_vector_type(2)));
typedef unsigned u32x4 __attribute__((ext_vector_type(4)));
typedef __bf16 bf16x2_t __attribute__((ext_vector_type(2)));
typedef GAS unsigned gu32;

constexpr int D = 1024, NB = 4, SEQ = 4096, NMETA = 16;
constexpr int LB = 4160;
constexpr int RP = NB * LB;
constexpr int RC = NB * SEQ;
constexpr int LPOS = NMETA + SEQ;
constexpr int GH = 4, GDK = 128, GDV = 256, NCH = 65;
constexpr int MH = 16, MQD = 96, MQR = 384, MKVR = 256;
constexpr int INW = 5808, INWP = 5888;
constexpr int NEXP = 32, EFF = 256;
constexpr float ALPHA = 1.189207115002721f;
constexpr float LN_EPS = 1e-5f, RMS_EPS = 1e-6f;
constexpr float QSCALE2 = 0.10206207261596577f * 1.4426950408889634f;
constexpr float GLA_QS = 0.08838834764831845f;
constexpr int MAXT = 160;

constexpr size_t MiB = 1u << 20;
constexpr size_t WS_CTL = 0, CTL_ZERO_BYTES = 65536;
constexpr size_t WS_SMALL = 1 * MiB;
constexpr size_t SM_COS = WS_SMALL, SM_SIN = SM_COS + 266240, SM_RSQ = SM_SIN + 266240, SM_RSKV = SM_RSQ + 69632, SM_DEC = SM_RSKV + 69632,
                 SM_ROUTE = SM_DEC + 540672, SM_HIST = SM_ROUTE + 262144, SM_SLOT = SM_HIST + 32768, SM_CW = SM_SLOT + 131072, SM_TILE = SM_CW + 163840, SM_END = SM_TILE + 4096;
static_assert(SM_END <= 5 * MiB, "small region");
constexpr size_t WS_WIN = 5 * MiB;
constexpr size_t WS_WUQ = WS_WIN + (size_t)INWP * 1024 * 2;
constexpr size_t WS_WUKV = WS_WUQ + (size_t)1536 * 384 * 2;
constexpr size_t WS_WBR = WS_WUKV + (size_t)2048 * 256 * 2;
constexpr size_t WS_WOUT = WS_WBR + (size_t)1024 * 2048 * 2;
static_assert(WS_WOUT + (size_t)1024 * 1024 * 2 <= 26 * MiB, "weights region");
constexpr size_t WS_S0 = 26 * MiB;
constexpr size_t WS_KG = WS_S0 + (size_t)RP * 1024 * 2;
constexpr size_t WS_CQ = WS_KG + (size_t)RP * 512 * 2;
static_assert(WS_CQ + (size_t)RP * 384 * 2 <= 87 * MiB, "cq");
constexpr size_t WS_OG = 95 * MiB;
constexpr size_t WS_GA = 127 * MiB, WS_GB = 159 * MiB;
constexpr size_t WS_U = 191 * MiB;
constexpr size_t WS_KN = 191 * MiB;
constexpr size_t WS_VV = WS_KN + (size_t)RP * 1024 * 2;
static_assert(WS_VV + (size_t)RP * 1024 * 2 <= 256 * MiB, "kv");
constexpr size_t WS_OM = WS_KG;
static_assert(WS_OM + (size_t)RC * 1024 * 2 <= WS_OG, "om");
constexpr size_t WS_MERGED = 191 * MiB;
constexpr size_t WS_S1B = 26 * MiB;
constexpr size_t WS_WGU = 58 * MiB;
constexpr size_t WS_WD = 90 * MiB;
constexpr size_t WS_XS = 106 * MiB;
constexpr size_t WS_HID = 186 * MiB;
constexpr size_t WS_YS = WS_XS;
static_assert(WS_HID + (size_t)MAXT * 256 * 256 * 2 <= 256 * MiB, "hid");
constexpr size_t OA_VG = 0;
constexpr size_t OA_QG = OA_VG + (size_t)RP * 1024 * 2;
constexpr size_t OA_CKV = OA_QG + (size_t)RP * 512 * 2;
constexpr size_t OA_KR = 57 * MiB;
constexpr size_t OA_ALR = 59 * MiB;
static_assert(OA_CKV + (size_t)RP * 256 * 2 <= OA_KR && OA_ALR + (size_t)RP * 16 * 4 <= 64 * MiB, "out arena");
constexpr size_t OA_Q = 0;

#define RLX_AGENT __ATOMIC_RELAXED, __HIP_MEMORY_SCOPE_AGENT
#define LDS_WAIT() asm volatile("s_waitcnt lgkmcnt(0)" ::: "memory")
#define VM_WAIT() asm volatile("s_waitcnt vmcnt(0)" ::: "memory")
__device__ __forceinline__ unsigned cvtpk(float lo, float hi) { f32x2 v = {lo, hi}; bf16x2_t b = __builtin_convertvector(v, bf16x2_t); return __builtin_bit_cast(unsigned, b); }
__device__ __forceinline__ bf16 f2bf(float f) { return (bf16)(cvtpk(f, 0.f) & 0xffffu); }
__device__ __forceinline__ float bf2f(unsigned u) { return __uint_as_float(u << 16); }
__device__ __forceinline__ float bflo(unsigned w) { return __uint_as_float(w << 16); }
__device__ __forceinline__ float bfhi(unsigned w) { return __uint_as_float(w & 0xffff0000u); }
__device__ __forceinline__ float wave_sum(float v) {
#pragma unroll
    for (int o = 1; o < 64; o <<= 1) v += __shfl_xor(v, o);
    return v;
}
__device__ __forceinline__ float sigmoidf_(float x) { return 1.f / (1.f + __expf(-x)); }
__device__ __forceinline__ int crow(int r, int hi) { return (r & 3) + 8 * (r >> 2) + 4 * hi; }

#define XB_TMO      128
#define XB_XCNT(j)  (256  + 64 * (j))
#define XB_XSUB(j)  (1280 + 64 * (j))
#define XB_XGEN(j)  (2304 + 64 * (j))
#define XB_TOP      3328
#define XB_TOPGEN   3392
#define XCD_BAR_WORDS 3456
#define XB_SPIN_CAP (1u << 22)
__device__ __forceinline__ unsigned xb_ld(unsigned* p)              { return __hip_atomic_load(p, __ATOMIC_RELAXED, __HIP_MEMORY_SCOPE_AGENT); }
__device__ __forceinline__ unsigned xb_add(unsigned* p, unsigned v) { return __hip_atomic_fetch_add(p, v, __ATOMIC_RELAXED, __HIP_MEMORY_SCOPE_AGENT); }
__device__ __forceinline__ unsigned xb_xcc_id() { return (unsigned)__builtin_amdgcn_s_getreg((3 << 11) | 20) & 0xFu; }
#define XB_SPIN(cond, bar) do { unsigned _sp = 0; while (cond) { __builtin_amdgcn_s_sleep(1); \
    if ((++_sp & 255u) == 0u) { if (xb_ld(&(bar)[XB_TMO])) break; if (_sp > XB_SPIN_CAP) { atomicAdd(&(bar)[XB_TMO], 1u); break; } } } } while (0)
struct XcdBarrier { unsigned* bar; unsigned x; volatile LAS unsigned* st; };
__device__ __forceinline__ XcdBarrier xcd_barrier_post(unsigned* bar, volatile LAS unsigned* st) {
    XcdBarrier b; b.bar = bar; b.x = xb_xcc_id(); b.st = st;
    if (threadIdx.x == 0) (void)xb_add(&bar[XB_XCNT(b.x)], 1u);
    return b;
}
__device__ __forceinline__ void xcd_barrier_complete(unsigned* bar, unsigned x, unsigned& nloc, unsigned& nx) {
    const unsigned G = gridDim.x * gridDim.y * gridDim.z;
    unsigned sum, cnt, mine, sp = 0u;
    for (;;) {
        sum = 0u; cnt = 0u; mine = 0u;
#pragma unroll
        for (unsigned j = 0; j < 16; ++j) { const unsigned c = xb_ld(&bar[XB_XCNT(j)]); sum += c; cnt += (c > 0u) ? 1u : 0u; mine = (j == x) ? c : mine; }
        if (sum == G) break;
        __builtin_amdgcn_s_sleep(1);
        if ((++sp & 255u) == 0u) { if (xb_ld(&bar[XB_TMO])) break; if (sp > XB_SPIN_CAP) { atomicAdd(&bar[XB_TMO], 1u); break; } }
    }
    nloc = mine > 0u ? mine : 1u; nx = cnt > 0u ? cnt : 1u;
}
__device__ __forceinline__ void xcd_barrier(const XcdBarrier& b) {
    asm volatile("s_waitcnt vmcnt(0)" ::: "memory");
    __syncthreads();
    if (threadIdx.x == 0) {
        unsigned* bar = b.bar;
        __builtin_amdgcn_s_waitcnt(0);
        unsigned nloc = b.st[0], nx = b.st[1];
        if (nloc == 0u) { xcd_barrier_complete(bar, b.x, nloc, nx); b.st[0] = nloc; b.st[1] = nx; }
        const unsigned old = xb_add(&bar[XB_XSUB(b.x)], 1u);
        const unsigned gen = old / nloc;
        if (old + 1u == (gen + 1u) * nloc) {
            __builtin_amdgcn_fence(__ATOMIC_RELEASE, "agent");
            asm volatile("s_waitcnt vmcnt(0)" ::: "memory");
            const unsigned og = xb_add(&bar[XB_TOP], 1u);
            const unsigned tg = og / nx;
            if (og + 1u == (tg + 1u) * nx) xb_add(&bar[XB_TOPGEN], 1u);
            else XB_SPIN(xb_ld(&bar[XB_TOPGEN]) == tg, bar);
            __builtin_amdgcn_fence(__ATOMIC_ACQUIRE, "agent");
            xb_add(&bar[XB_XGEN(b.x)], 1u);
            asm volatile("s_waitcnt vmcnt(0)" ::: "memory");
        } else {
            XB_SPIN(xb_ld(&bar[XB_XGEN(b.x)]) == gen, bar);
            __builtin_amdgcn_fence(__ATOMIC_ACQUIRE, "agent");
            asm volatile("s_waitcnt vmcnt(0)" ::: "memory");
        }
    }
    __syncthreads();
}

namespace pg8 {
constexpr int BM = 256, BK = 64, HALF = 128, HTB = HALF * BK * 2, STAGE_BYTES = 8 * HTB, NXCD = 8, WGM = 8;
__host__ __device__ __forceinline__ int lds_byte(int r, int c) { const int st = (r >> 4) * 2 + (c >> 5), rr = r & 15, cc = c & 31, ob = rr * 64 + cc * 2; return st * 1024 + (ob ^ (((ob >> 9) & 1) << 5)); }
__host__ __device__ __forceinline__ void stage_rc(int b, int& R, int& C) { const int st = b / 1024, sb = b % 1024, swz = sb ^ (((sb >> 9) & 1) << 5); R = (st >> 1) * 16 + swz / 64; C = (st & 1) * 32 + (swz % 64) / 2; }
__host__ __device__ __forceinline__ int perm32(int rho) { const int n = rho >> 4, i = rho & 15; return 8 * (i >> 2) + 4 * n + (i & 3); }

struct Unit { int pm, pn, aux; const char* a; const char* a2; const char* b; };

__device__ __forceinline__ void tile_of(int L, int nM, int nN, int& pm, int& pn) {
    const int nwg = nM * nN; int wgid = L; { const int q = nwg / NXCD, r = nwg % NXCD, xcd = wgid % NXCD, off = wgid / NXCD; wgid = (xcd < r ? xcd * (q + 1) : r * (q + 1) + (xcd - r) * q) + off; }
    const int nig = WGM * nN, gid = wgid / nig, fm = gid * WGM, gsz = (nM - fm) < WGM ? (nM - fm) : WGM;
    pm = fm + ((wgid % nig) % gsz); pn = (wgid % nig) / gsz;
}

template <class Epi, class Sched, bool ALIGN_EPI>
__device__ __forceinline__ void gemm_phase(LAS unsigned char* lds, const int lda, const int ldb, const int K, const int ksplit, const Sched& S, const Epi& E) {
    const int tid = threadIdx.x, wid = __builtin_amdgcn_readfirstlane(tid >> 6), lane = tid & 63, wr = wid >> 2, wc = wid & 3, fr = lane & 15, fq = lane >> 4;
    const int nt = K / BK;
    unsigned voffA[2], voffB[2];
#pragma unroll
    for (int i = 0; i < 2; ++i) { int R, C; stage_rc(tid * 16 + i * 8192, R, C); const int Rb = Epi::PERM ? ((R & ~31) + perm32(R & 31)) : R;
        voffA[i] = (unsigned)(R * lda + C) * 2u; voffB[i] = (unsigned)(Rb * ldb + C) * 2u; }
    const size_t kstep = (size_t)(BK * 2);
    const size_t hstepA = (size_t)HALF * lda * 2, hstepB = (size_t)HALF * ldb * 2;
    const unsigned ldsw = (unsigned)wid * 1024u;
    const int aoff = lds_byte(wr * 64 + fr, fq * 8), boff = lds_byte(wc * 32 + fr, fq * 8);
#define PG8_SA(b, h) (((b) * 2 + (h)) * HTB)
#define PG8_SB(b, h) ((4 + (b) * 2 + (h)) * HTB)
#define PG8_STAGE(bufoff, gbase, voff) do { _Pragma("unroll") for (int _i = 0; _i < 2; ++_i) \
        __builtin_amdgcn_global_load_lds((const unsigned*)((const char*)(gbase) + (voff)[_i]), (LAS unsigned*)(lds + (bufoff) + ldsw + _i * 8192), 16, 0, 0); } while (0)
#define PG8_LDA(dst, b, h) do { _Pragma("unroll") for (int m = 0; m < 4; ++m) _Pragma("unroll") for (int k = 0; k < 2; ++k) dst[m][k] = *(const LAS bf16x8*)(lds + PG8_SA(b, h) + aoff + m * 2048 + k * 1024); } while (0)
#define PG8_LDB(dst, b, h) do { _Pragma("unroll") for (int n = 0; n < 2; ++n) _Pragma("unroll") for (int k = 0; k < 2; ++k) dst[n][k] = *(const LAS bf16x8*)(lds + PG8_SB(b, h) + boff + n * 2048 + k * 1024); } while (0)
#define PG8_MMA(ai, bj, At, Bt) do { __builtin_amdgcn_s_setprio(1); _Pragma("unroll") for (int m = 0; m < 4; ++m) _Pragma("unroll") for (int n = 0; n < 2; ++n) _Pragma("unroll") for (int k = 0; k < 2; ++k) \
        acc[ai][bj][m][n] = __builtin_amdgcn_mfma_f32_16x16x32_bf16(Bt[n][k], At[m][k], acc[ai][bj][m][n], 0, 0, 0); __builtin_amdgcn_s_setprio(0); } while (0)
#define PG8_WAIT_V(n) asm volatile("s_waitcnt vmcnt(" #n ")" ::: "memory")
#define PG8_WAIT_L(n) asm volatile("s_waitcnt lgkmcnt(" #n ")" ::: "memory")
#define PG8_BAR __builtin_amdgcn_s_barrier()
#define PG8_SCHED __builtin_amdgcn_sched_barrier(0)
#define PG8_KA(u, t) (((t) < ksplit) ? (u).a + (size_t)(t) * kstep : (u).a2 + (size_t)((t) - ksplit) * kstep)
    Unit cur, nxt; int ui = 0;
    if (!S.next(0, cur)) return;
    f32x4 acc[2][2][4][2];
#pragma unroll
    for (int a = 0; a < 2; ++a)
#pragma unroll
        for (int b = 0; b < 2; ++b)
#pragma unroll
            for (int m = 0; m < 4; ++m)
#pragma unroll
                for (int n = 0; n < 2; ++n) acc[a][b][m][n] = (f32x4){0.f, 0.f, 0.f, 0.f};
    bf16x8 At[4][2], B0[2][2], B1[2][2];
    {
        const char* cA = cur.a; const char* cA1 = PG8_KA(cur, 1); const char* cB = cur.b;
        PG8_STAGE(PG8_SB(0, 0), cB, voffB); PG8_STAGE(PG8_SB(0, 1), cB + hstepB, voffB); PG8_STAGE(PG8_SA(0, 0), cA, voffA); PG8_STAGE(PG8_SA(0, 1), cA + hstepA, voffA);
        if (wr == 1) PG8_BAR;
        PG8_WAIT_V(2); PG8_BAR;
        PG8_STAGE(PG8_SB(1, 0), cB + kstep, voffB); PG8_STAGE(PG8_SA(1, 0), cA1, voffA); PG8_STAGE(PG8_SB(1, 1), cB + hstepB + kstep, voffB);
        PG8_WAIT_V(6); PG8_BAR;
    }
    for (;;) {
        const bool has_next = S.next(ui + 1, nxt);
#pragma clang loop unroll(disable)
        for (int t = 0; t < nt; t += 2) {
            const bool last = (t == nt - 2);
            if (Epi::HAS_MID) { if (t == ksplit) E.mid(acc, cur, wr, wc, fr, fq); }
            const char* a1 = PG8_KA(cur, t + 1);
            const char* a2; const char* a3; const char* b2;
            if (last) { if (has_next) { a2 = PG8_KA(nxt, 0); a3 = PG8_KA(nxt, 1); b2 = nxt.b; } else { a2 = PG8_KA(cur, 0); a3 = PG8_KA(cur, 1); b2 = cur.b; } }
            else { a2 = PG8_KA(cur, t + 2); a3 = PG8_KA(cur, t + 3); b2 = cur.b + (size_t)(t + 2) * kstep; }
            const char* b3 = b2 + kstep;
            PG8_LDB(B0, 0, 0); PG8_LDB(B1, 0, 1); PG8_SCHED; PG8_LDA(At, 0, 0); PG8_STAGE(PG8_SA(1, 1), a1 + hstepA, voffA);
            PG8_WAIT_V(8); PG8_WAIT_L(0); PG8_BAR; PG8_MMA(0, 0, At, B0); PG8_MMA(0, 1, At, B1); PG8_BAR; PG8_SCHED;
            PG8_LDA(At, 0, 1); PG8_STAGE(PG8_SB(0, 0), b2, voffB); PG8_STAGE(PG8_SB(0, 1), b2 + hstepB, voffB); PG8_STAGE(PG8_SA(0, 0), a2, voffA);
            PG8_WAIT_V(8); PG8_WAIT_L(0); PG8_BAR; PG8_MMA(1, 0, At, B0); PG8_MMA(1, 1, At, B1); PG8_BAR; PG8_SCHED;
            PG8_LDB(B0, 1, 0); PG8_LDB(B1, 1, 1); PG8_SCHED; PG8_LDA(At, 1, 0); PG8_STAGE(PG8_SA(0, 1), a2 + hstepA, voffA);
            PG8_WAIT_V(8); PG8_WAIT_L(0); PG8_BAR; PG8_MMA(0, 0, At, B0); PG8_MMA(0, 1, At, B1); PG8_BAR; PG8_SCHED;
            PG8_LDA(At, 1, 1); PG8_STAGE(PG8_SB(1, 0), b3, voffB); PG8_STAGE(PG8_SB(1, 1), b3 + hstepB, voffB); PG8_STAGE(PG8_SA(1, 0), a3, voffA);
            PG8_WAIT_V(8); PG8_WAIT_L(0); PG8_BAR; PG8_MMA(1, 0, At, B0); PG8_MMA(1, 1, At, B1); PG8_BAR; PG8_SCHED;
        }
        if constexpr (ALIGN_EPI) { if (wr == 0) PG8_BAR; }
        E(acc, cur, wr, wc, fr, fq);
        if (!has_next) break;
#pragma unroll
        for (int a = 0; a < 2; ++a)
#pragma unroll
            for (int b = 0; b < 2; ++b)
#pragma unroll
                for (int m = 0; m < 4; ++m)
#pragma unroll
                    for (int n = 0; n < 2; ++n) acc[a][b][m][n] = (f32x4){0.f, 0.f, 0.f, 0.f};
        cur = nxt; ++ui;
        if constexpr (ALIGN_EPI) { if (wr == 1) PG8_BAR; }
    }
    PG8_WAIT_V(0);
    if constexpr (!ALIGN_EPI) { if (wr == 0) PG8_BAR; }
    PG8_BAR;
#undef PG8_SA
#undef PG8_SB
#undef PG8_STAGE
#undef PG8_LDA
#undef PG8_LDB
#undef PG8_MMA
#undef PG8_WAIT_V
#undef PG8_WAIT_L
#undef PG8_BAR
#undef PG8_SCHED
#undef PG8_KA
}
}
typedef f32x4 Acc[2][2][4][2];

struct Args {
    const float* in[27]; float* out; unsigned char* ws; int ph_lo, ph_hi;
};
constexpr int NWAVES = 8;
constexpr int LDS_BYTES = 147456;
constexpr int MISC_OFF = 131072 + 320;

struct Frame {
    LAS unsigned char* lds; char* ldsg;
    int tid, lane, wave, vcu, G;
    unsigned char* ws; unsigned char* oa;
    const float* const* in;
};
enum { I_X = 0, I_META, I_LNE_G, I_LNE_B, I_WIN, I_GW2, I_GB, I_GNORM, I_QNG, I_WUQ, I_KVNG, I_WUK, I_WUV, I_WBG, I_WBM, I_WOUT, I_LNM_G, I_LNM_B,
       I_RGW, I_RGB, I_REW, I_REB, I_EWG, I_EWU, I_EWD, I_LNF_G, I_LNF_B };

struct TSrc { const float* p0; const float* p1; const float* ks; int mode; };
__device__ __forceinline__ int win_src_col(int n) {
    if (n < 3072) return n;
    if (n < 3328) return 3472 + (n - 3072);
    if (n < 3712) return 3088 + (n - 3328);
    if (n < 3744) { const int p = n - 3712; return 3728 + 16 * ((p >> 2) & 1) + 4 * (p >> 3) + (p & 3); }
    if (n < 3760) return 3072 + (n - 3744);
    if (n < 3840) return -1;
    if (n < 4864) return 3760 + (n - 3840);
    return 4784 + (n - 4864);
}
__device__ __forceinline__ float tsrc_val(const TSrc& s, int k, int n) {
    switch (s.mode) {
        case 0: { const int c = win_src_col(n); return c < 0 ? 0.f : s.p0[(size_t)k * INW + c]; }
        case 1: { const int h = n / 96, p = n % 96; int c = n; if (p >= 64) { const int pp = p - 64; c = h * 96 + 64 + 16 * ((pp >> 2) & 1) + 4 * (pp >> 3) + (pp & 3); } return s.p0[(size_t)k * 1536 + c] * s.ks[k]; }
        case 2: return (n < 1024 ? s.p0[(size_t)k * 1024 + n] : s.p1[(size_t)k * 1024 + n - 1024]) * s.ks[k];
        case 3: return k < 1024 ? s.p0[(size_t)k * 1024 + n] : s.p1[(size_t)(k - 1024) * 1024 + n];
        case 4: return s.p0[(size_t)k * 1024 + n];
        case 5: { const int f = 128 * (n >> 8) + (n & 127); return ((n >> 7) & 1) ? s.p1[(size_t)k * 256 + f] : s.p0[(size_t)k * 256 + f]; }
        default: return s.p0[(size_t)k * 1024 + n];
    }
}
__device__ __forceinline__ void transpose_item(const TSrc& s, int Kd, int N, bf16* WT, LAS float* scr, int item, int lane) {
    const int nblk = N / 32, kb = item / nblk, nb = item % nblk, k0 = 64 * kb, n0 = 32 * nb;
#pragma unroll 8
    for (int i = 0; i < 32; ++i) { const int kk = 2 * i + (lane >> 5); scr[kk * 33 + (lane & 31)] = tsrc_val(s, k0 + kk, n0 + (lane & 31)); }
    LDS_WAIT(); asm volatile("" ::: "memory");
    const int c = lane & 7;
#pragma unroll
    for (int j = 0; j < 4; ++j) { const int n = (lane >> 3) + 8 * j; const LAS float* p = scr + (8 * c) * 33 + n;
        u32x4 o; o.x = cvtpk(p[0 * 33], p[1 * 33]); o.y = cvtpk(p[2 * 33], p[3 * 33]); o.z = cvtpk(p[4 * 33], p[5 * 33]); o.w = cvtpk(p[6 * 33], p[7 * 33]);
        *(GAS u32x4*)(WT + (size_t)(n0 + n) * Kd + k0 + 8 * c) = o; }
    LDS_WAIT(); asm volatile("" ::: "memory");
}
__device__ __forceinline__ void ln_row_bf16(const float* xrow, const float* g, const float* b, bf16* orow, int lane) {
    const f32x4* xr = (const f32x4*)xrow + lane;
    f32x4 v[4]; float s = 0.f;
#pragma unroll
    for (int j = 0; j < 4; ++j) { v[j] = xr[64 * j]; s += (v[j].x + v[j].y) + (v[j].z + v[j].w); }
    const float mean = wave_sum(s) * (1.f / D); float s2 = 0.f;
#pragma unroll
    for (int j = 0; j < 4; ++j) { v[j] = v[j] - mean; s2 += (v[j].x * v[j].x + v[j].y * v[j].y) + (v[j].z * v[j].z + v[j].w * v[j].w); }
    const float rstd = 1.f / sqrtf(wave_sum(s2) * (1.f / D) + LN_EPS);
    u32x2* o8 = (u32x2*)orow + lane;
#pragma unroll
    for (int j = 0; j < 4; ++j) { const f32x4 gg = ((const f32x4*)g)[lane + 64 * j], bb = ((const f32x4*)b)[lane + 64 * j]; const f32x4 y = v[j] * rstd * gg + bb;
        u32x2 w; w.x = cvtpk(y.x, y.y); w.y = cvtpk(y.z, y.w); o8[64 * j] = w; }
}
__device__ __forceinline__ void p0_prologue(Frame& F) {
    LAS float* scr = (LAS float*)(F.lds + F.wave * 16384);
    const int gw = F.vcu * NWAVES + F.wave, NGW = F.G * NWAVES;
    constexpr int I0 = (1024 / 64) * (INWP / 32), I1 = (384 / 64) * (1536 / 32), I2 = (256 / 64) * (2048 / 32), I3 = (2048 / 64) * (1024 / 32), I4 = (1024 / 64) * (1024 / 32);
    constexpr int NIT = I0 + I1 + I2 + I3 + I4;
    for (int it = gw; it < NIT; it += NGW) {
        int r = it; TSrc s;
        if (r < I0) { s = TSrc{F.in[I_WIN], nullptr, nullptr, 0}; transpose_item(s, 1024, INWP, (bf16*)(F.ws + WS_WIN), scr, r, F.lane); continue; } r -= I0;
        if (r < I1) { s = TSrc{F.in[I_WUQ], nullptr, F.in[I_QNG], 1}; transpose_item(s, 384, 1536, (bf16*)(F.ws + WS_WUQ), scr, r, F.lane); continue; } r -= I1;
        if (r < I2) { s = TSrc{F.in[I_WUK], F.in[I_WUV], F.in[I_KVNG], 2}; transpose_item(s, 256, 2048, (bf16*)(F.ws + WS_WUKV), scr, r, F.lane); continue; } r -= I2;
        if (r < I3) { s = TSrc{F.in[I_WBG], F.in[I_WBM], nullptr, 3}; transpose_item(s, 2048, 1024, (bf16*)(F.ws + WS_WBR), scr, r, F.lane); continue; } r -= I3;
        s = TSrc{F.in[I_WOUT], nullptr, nullptr, 4}; transpose_item(s, 1024, 1024, (bf16*)(F.ws + WS_WOUT), scr, r, F.lane);
    }
    bf16* S0 = (bf16*)(F.ws + WS_S0);
    for (int rp = gw; rp < RP; rp += NGW) {
        const int b = rp / LB, j = rp % LB; bf16* orow = S0 + (size_t)rp * D;
        if (j < 48) { u32x4* o = (u32x4*)orow + F.lane; o[0] = (u32x4){0, 0, 0, 0}; o[64] = (u32x4){0, 0, 0, 0}; }
        else { const float* src = (j < 64) ? F.in[I_META] + (size_t)(j - 48) * D : F.in[I_X] + ((size_t)b * SEQ + (j - 64)) * D; ln_row_bf16(src, F.in[I_LNE_G], F.in[I_LNE_B], orow, F.lane); }
    }
    const int gt = F.vcu * NWAVES * 64 + F.tid, NGT = F.G * NWAVES * 64;
    float* COS = (float*)(F.ws + SM_COS); float* SIN = (float*)(F.ws + SM_SIN);
    for (int i = gt; i < LPOS * 16; i += NGT) { const int pos = i >> 4, k = i & 15; const double inv = exp2(-(double)k * (2.0 / 32.0) * 13.287712379549449);
        const double ang = (double)pos * inv; COS[i] = (float)cos(ang); SIN[i] = (float)sin(ang); }
    float* RSQ = (float*)(F.ws + SM_RSQ); float* RSKV = (float*)(F.ws + SM_RSKV);
    for (int i = gt; i < RP; i += NGT) { RSQ[i] = 0.f; RSKV[i] = 0.f; }
}

struct SchedP1 {
    const char* A; const char* B; int G, c;
    __device__ __forceinline__ bool next(int i, pg8::Unit& u) const {
        const int L = i * G + c; if (L >= 65 * 23) return false;
        pg8::tile_of(L, 65, 23, u.pm, u.pn); u.aux = 0;
        u.a = A + (size_t)u.pm * 256 * 1024 * 2; u.a2 = u.a; u.b = B + (size_t)u.pn * 256 * 1024 * 2; return true;
    }
};
__device__ __forceinline__ void store8(bf16* p, const f32x4& v0, const f32x4& v1) {
    u32x4 w; w.x = cvtpk(v0[0], v0[1]); w.y = cvtpk(v0[2], v0[3]); w.z = cvtpk(v1[0], v1[1]); w.w = cvtpk(v1[2], v1[3]); *(u32x4*)p = w;
}
struct EpiP1 {
    static constexpr bool PERM = true, HAS_MID = false;
    unsigned char* ws; unsigned char* oa;
    __device__ __forceinline__ void mid(Acc&, const pg8::Unit&, int, int, int, int) const {}
    __device__ __forceinline__ void operator()(Acc& acc, const pg8::Unit& u, int wr, int wc, int fr, int fq) const {
        const int pn = u.pn; const int rbase = u.pm * 256 + wr * 64 + fr;
        if (pn < 8) {
            bf16* dst; int pitch, c0; float sc = 1.f;
            if (pn < 2) { dst = (bf16*)(oa + OA_QG); pitch = 512; c0 = pn * 256; sc = GLA_QS; }
            else if (pn < 4) { dst = (bf16*)(ws + WS_KG); pitch = 512; c0 = (pn - 2) * 256; }
            else { dst = (bf16*)(oa + OA_VG); pitch = 1024; c0 = (pn - 4) * 256; }
#pragma unroll
            for (int ai = 0; ai < 2; ++ai)
#pragma unroll
                for (int m = 0; m < 4; ++m) { bf16* rowp = dst + (size_t)(rbase + ai * 128 + m * 16) * pitch + c0 + wc * 32 + 8 * fq;
#pragma unroll
                    for (int bj = 0; bj < 2; ++bj) store8(rowp + bj * 128, acc[ai][bj][m][0] * sc, acc[ai][bj][m][1] * sc); }
        } else if (pn < 12 || pn >= 15) {
            bf16* dst; int c0; const bool is_r = pn < 12;
            if (is_r) { dst = (bf16*)(ws + WS_OG); c0 = (pn - 8) * 256; } else if (pn < 19) { dst = (bf16*)(ws + WS_GA); c0 = (pn - 15) * 256; } else { dst = (bf16*)(ws + WS_GB); c0 = (pn - 19) * 256; }
#pragma unroll
            for (int ai = 0; ai < 2; ++ai)
#pragma unroll
                for (int m = 0; m < 4; ++m) { const int rp = rbase + ai * 128 + m * 16; const int b = rp / LB, j = rp - b * LB;
                    if (j >= 64) { bf16* rowp = dst + (size_t)(b * SEQ + j - 64) * 1024 + c0 + wc * 32 + 8 * fq;
#pragma unroll
                        for (int bj = 0; bj < 2; ++bj) { f32x4 v0 = acc[ai][bj][m][0], v1 = acc[ai][bj][m][1];
#pragma unroll
                            for (int e = 0; e < 4; ++e) { const float s0 = sigmoidf_(v0[e]), s1 = sigmoidf_(v1[e]); v0[e] = is_r ? v0[e] * s0 : s0; v1[e] = is_r ? v1[e] * s1 : s1; }
                            store8(rowp + bj * 128, v0, v1); } } }
        } else {
            bf16* dst; int pitch, c0; float* rs;
            if (pn == 12) { dst = (bf16*)(oa + OA_CKV); pitch = 256; c0 = 0; rs = (float*)(ws + SM_RSKV); }
            else { dst = (bf16*)(ws + WS_CQ); pitch = 384; c0 = (pn - 13) * 256; rs = (float*)(ws + SM_RSQ); }
            const int nbj = (pn == 14) ? 1 : 2;
#pragma unroll
            for (int ai = 0; ai < 2; ++ai)
#pragma unroll
                for (int m = 0; m < 4; ++m) { const int rp = rbase + ai * 128 + m * 16; bf16* rowp = dst + (size_t)rp * pitch + c0 + wc * 32 + 8 * fq; float ss = 0.f;
#pragma unroll
                    for (int bj = 0; bj < 2; ++bj) if (bj < nbj) { const f32x4 v0 = acc[ai][bj][m][0], v1 = acc[ai][bj][m][1];
                        ss += (v0[0] * v0[0] + v0[1] * v0[1]) + (v0[2] * v0[2] + v0[3] * v0[3]) + (v1[0] * v1[0] + v1[1] * v1[1]) + (v1[2] * v1[2] + v1[3] * v1[3]);
                        store8(rowp + bj * 128, v0, v1); }
                    ss += __shfl_xor(ss, 16); ss += __shfl_xor(ss, 32);
                    if (fq == 0) atomicAdd(rs + rp, ss);
                    if (pn == 14) {
                        if (wc == 0) {
                            const int b = rp / LB, j = rp - b * LB; const int pos = j >= 48 ? j - 48 : 0;
                            const f32x4 cs = *(const f32x4*)((const float*)(ws + SM_COS) + pos * 16 + 4 * fq), sn = *(const f32x4*)((const float*)(ws + SM_SIN) + pos * 16 + 4 * fq);
                            const f32x4 x1 = acc[ai][1][m][0], x2 = acc[ai][1][m][1]; const f32x4 o1 = x1 * cs - x2 * sn, o2 = x1 * sn + x2 * cs;
                            bf16* kr = (bf16*)(oa + OA_KR) + (size_t)rp * 32; u32x2 w1, w2; w1.x = cvtpk(o1[0], o1[1]); w1.y = cvtpk(o1[2], o1[3]); w2.x = cvtpk(o2[0], o2[1]); w2.y = cvtpk(o2[2], o2[3]);
                            *(u32x2*)(kr + 4 * fq) = w1; *(u32x2*)(kr + 16 + 4 * fq) = w2;
                        } else if (wc == 1 && fq < 2) {
                            float* al = (float*)(oa + OA_ALR) + (size_t)rp * 16 + 8 * fq; *(f32x4*)al = acc[ai][1][m][0]; *(f32x4*)(al + 4) = acc[ai][1][m][1];
                        }
                    } }
        }
    }
};

constexpr int GL_BC = 0;
constexpr int GL_SEG = 33280;
constexpr int GL_ALR = 35328;
constexpr int GL_KE = 39424;
constexpr int GL_KT = 57856;
constexpr int GL_ATT = 75264;
constexpr int GL_V = 84480;
constexpr int GL_SS = 118272;
static_assert(GL_SS + 2048 <= 131072, "gla lds");

__device__ __forceinline__ s16x4 tr16(const LAS void* p) { typedef short v4i16_t __attribute__((ext_vector_type(4))); return __builtin_bit_cast(s16x4, __builtin_amdgcn_ds_read_tr16_b64_v4i16((LAS v4i16_t*)p)); }
__device__ __forceinline__ float logsigmoid_(float z) { return fminf(z, 0.f) - log1pf(__expf(-fabsf(z))); }

__device__ __forceinline__ void gla_bc(Frame& F, int b, int h, int n, float (&bc)[16], float& blast) {
    const int tid = F.tid, d = tid & 127, rg = tid >> 7; const int rp0 = b * LB + 64 * n;
    LAS float* BC = (LAS float*)(F.lds + GL_BC); LAS float* SEG = (LAS float*)(F.lds + GL_SEG); LAS float* AL = (LAS float*)(F.lds + GL_ALR);
    { const float* alr = (const float*)(F.oa + OA_ALR) + (size_t)rp0 * 16; AL[tid] = alr[tid]; AL[tid + 512] = alr[tid + 512]; }
    float w2[16];
#pragma unroll
    for (int k = 0; k < 16; ++k) w2[k] = F.in[I_GW2][k * 512 + h * 128 + d];
    const float bias = F.in[I_GB][h * 128 + d];
    __syncthreads();
    float run = 0.f;
#pragma unroll
    for (int i = 0; i < 16; ++i) { const int row = 16 * rg + i; float z = bias;
#pragma unroll
        for (int k = 0; k < 16; ++k) z += AL[row * 16 + k] * w2[k];
        float la = logsigmoid_(z) * (1.f / 16.f); if (n == 0 && row < 48) la = 0.f;
        run += la; bc[i] = run; }
    SEG[rg * 128 + d] = run;
    __syncthreads();
    float off = 0.f, tot = 0.f;
#pragma unroll
    for (int g = 0; g < 4; ++g) { const float s = SEG[g * 128 + d]; tot += s; if (g < rg) off += s; }
#pragma unroll
    for (int i = 0; i < 16; ++i) bc[i] += off;
    blast = tot;
    (void)BC;
}

__device__ __forceinline__ void gla_g1_unit(Frame& F, int b, int h, int n) {
    const int tid = F.tid, lane = F.lane, w = F.wave, d = tid & 127, rg = tid >> 7; const int rp0 = b * LB + 64 * n; const int unit = (b * GH + h) * NCH + n;
    float bc[16], blast; gla_bc(F, b, h, n, bc, blast);
    { const bf16* kg = (const bf16*)(F.ws + WS_KG) + (size_t)rp0 * 512 + h * 128 + d; LAS bf16* KE = (LAS bf16*)(F.lds + GL_KE) + d * 72 + 16 * rg; unsigned pk[8];
#pragma unroll
        for (int i = 0; i < 16; i += 2) { const float k0 = bf2f(kg[(size_t)(16 * rg + i) * 512]) * __expf(blast - bc[i]), k1 = bf2f(kg[(size_t)(16 * rg + i + 1) * 512]) * __expf(blast - bc[i + 1]); pk[i >> 1] = cvtpk(k0, k1); }
        *(LAS u32x4*)KE = (u32x4){pk[0], pk[1], pk[2], pk[3]}; *(LAS u32x4*)(KE + 8) = (u32x4){pk[4], pk[5], pk[6], pk[7]};
        if (rg == 0) ((float*)(F.ws + SM_DEC))[unit * 128 + d] = __expf(blast); }
    { const bf16* vg = (const bf16*)(F.oa + OA_VG) + (size_t)rp0 * 1024 + h * 256;
#pragma unroll
        for (int i = 0; i < 4; ++i) { const int p = tid + 512 * i, row = p >> 5, c = p & 31; *(LAS u32x4*)((LAS bf16*)(F.lds + GL_V) + row * 264 + c * 8) = *(const u32x4*)(vg + (size_t)row * 1024 + c * 8); } }
    __syncthreads();
    const int r32 = lane & 31, hi = lane >> 5, g4 = lane >> 4, q4 = (lane & 15) >> 2, p4 = lane & 3;
    bf16x8 bv[4];
#pragma unroll
    for (int ks = 0; ks < 4; ++ks) { const LAS bf16* vb = (const LAS bf16*)(F.lds + GL_V) + (16 * ks + 8 * (g4 >> 1) + q4) * 264 + 32 * w + 16 * (g4 & 1) + 4 * p4;
        const s16x4 lo = tr16(vb), hi4 = tr16(vb + 4 * 264); bv[ks] = (bf16x8){lo[0], lo[1], lo[2], lo[3], hi4[0], hi4[1], hi4[2], hi4[3]}; }
    bf16* U = (bf16*)(F.ws + WS_U) + (size_t)unit * 32768;
#pragma unroll
    for (int dt = 0; dt < 4; ++dt) { f32x16 c = {};
#pragma unroll
        for (int ks = 0; ks < 4; ++ks) { const bf16x8 a = *(const LAS bf16x8*)((const LAS bf16*)(F.lds + GL_KE) + (32 * dt + r32) * 72 + 16 * ks + 8 * hi); c = __builtin_amdgcn_mfma_f32_32x32x16_bf16(a, bv[ks], c, 0, 0, 0); }
#pragma unroll
        for (int g = 0; g < 4; ++g) { u32x2 o; o.x = cvtpk(c[4 * g], c[4 * g + 1]); o.y = cvtpk(c[4 * g + 2], c[4 * g + 3]); *(u32x2*)(U + (size_t)(32 * w + r32) * 128 + 32 * dt + 8 * g + 4 * hi) = o; } }
    __syncthreads();
}
__device__ __forceinline__ void gla_g2(Frame& F) {
    const int gt = F.vcu * 512 + F.tid, NGT = F.G * 512;
    for (int idx = gt; idx < 16 * 256 * 32; idx += NGT) {
        const int bh = idx >> 13, rem = idx & 8191, v = rem >> 5, dg = rem & 31;
        u32x2* up = (u32x2*)((bf16*)(F.ws + WS_U) + (size_t)bh * NCH * 32768 + (size_t)v * 128 + 4 * dg);
        const f32x4* dp = (const f32x4*)((const float*)(F.ws + SM_DEC) + (size_t)bh * NCH * 128 + 4 * dg);
        f32x4 S = {0.f, 0.f, 0.f, 0.f};
#pragma unroll 13
        for (int n = 0; n < NCH; ++n) { const u32x2 u = up[(size_t)n * 8192]; const f32x4 dc = dp[n * 32];
            u32x2 o; o.x = cvtpk(S[0], S[1]); o.y = cvtpk(S[2], S[3]); up[(size_t)n * 8192] = o;
            S[0] = dc[0] * S[0] + bflo(u.x); S[1] = dc[1] * S[1] + bfhi(u.x); S[2] = dc[2] * S[2] + bflo(u.y); S[3] = dc[3] * S[3] + bfhi(u.y); }
    }
}
__device__ __forceinline__ void gla_g3_unit(Frame& F, int b, int h, int n) {
    const int tid = F.tid, lane = F.lane, w = F.wave, d = tid & 127, rg = tid >> 7; const int rp0 = b * LB + 64 * n; const int unit = (b * GH + h) * NCH + n;
    float bc[16], blast; gla_bc(F, b, h, n, bc, blast);
    { const bf16* qg = (const bf16*)(F.oa + OA_QG) + (size_t)rp0 * 512 + h * 128 + d; const bf16* kg = (const bf16*)(F.ws + WS_KG) + (size_t)rp0 * 512 + h * 128 + d;
        LAS bf16* QT = (LAS bf16*)(F.lds + GL_KE); LAS bf16* KT = (LAS bf16*)(F.lds + GL_KT);
#pragma unroll
        for (int i = 0; i < 16; ++i) { const int row = 16 * rg + i; const float e = __expf(bc[i]);
            QT[row * 136 + d] = f2bf(bf2f(qg[(size_t)row * 512]) * e); KT[row * 136 + d] = f2bf(bf2f(kg[(size_t)row * 512]) / e); } }
    { const bf16* vg = (const bf16*)(F.oa + OA_VG) + (size_t)rp0 * 1024 + h * 256;
#pragma unroll
        for (int i = 0; i < 4; ++i) { const int p = tid + 512 * i, row = p >> 5, c = p & 31; *(LAS u32x4*)((LAS bf16*)(F.lds + GL_V) + row * 264 + c * 8) = *(const u32x4*)(vg + (size_t)row * 1024 + c * 8); } }
    __syncthreads();
    const int r32 = lane & 31, hi = lane >> 5, g4 = lane >> 4, q4 = (lane & 15) >> 2, p4 = lane & 3;
    if (w < 4) { const int ct = w >> 1, st = w & 1; f32x16 c = {};
        if (st <= ct) {
#pragma unroll
            for (int ks = 0; ks < 8; ++ks) { const bf16x8 a = *(const LAS bf16x8*)((const LAS bf16*)(F.lds + GL_KE) + (32 * ct + r32) * 136 + 16 * ks + 8 * hi);
                const bf16x8 bb = *(const LAS bf16x8*)((const LAS bf16*)(F.lds + GL_KT) + (32 * st + r32) * 136 + 16 * ks + 8 * hi); c = __builtin_amdgcn_mfma_f32_32x32x16_bf16(a, bb, c, 0, 0, 0); } }
        LAS bf16* AT = (LAS bf16*)(F.lds + GL_ATT);
#pragma unroll
        for (int r = 0; r < 16; ++r) { const int cc = 32 * ct + crow(r, hi), s = 32 * st + r32; AT[cc * 72 + s] = f2bf(s <= cc ? c[r] : 0.f); } }
    __syncthreads();
    f32x16 o0 = {}, o1 = {};
#pragma unroll
    for (int ks = 0; ks < 4; ++ks) { const LAS bf16* vb = (const LAS bf16*)(F.lds + GL_V) + (16 * ks + 8 * (g4 >> 1) + q4) * 264 + 32 * w + 16 * (g4 & 1) + 4 * p4;
        const s16x4 lo = tr16(vb), hi4 = tr16(vb + 4 * 264); const bf16x8 a = (bf16x8){lo[0], lo[1], lo[2], lo[3], hi4[0], hi4[1], hi4[2], hi4[3]};
        const bf16x8 b0 = *(const LAS bf16x8*)((const LAS bf16*)(F.lds + GL_ATT) + r32 * 72 + 16 * ks + 8 * hi), b1 = *(const LAS bf16x8*)((const LAS bf16*)(F.lds + GL_ATT) + (32 + r32) * 72 + 16 * ks + 8 * hi);
        o0 = __builtin_amdgcn_mfma_f32_32x32x16_bf16(a, b0, o0, 0, 0, 0); o1 = __builtin_amdgcn_mfma_f32_32x32x16_bf16(a, b1, o1, 0, 0, 0); }
    { const bf16* sb = (const bf16*)(F.ws + WS_U) + (size_t)unit * 32768 + (size_t)(32 * w + r32) * 128 + 8 * hi;
#pragma unroll
        for (int ks = 0; ks < 8; ++ks) { const bf16x8 a = *(const bf16x8*)(sb + 16 * ks);
            const bf16x8 b0 = *(const LAS bf16x8*)((const LAS bf16*)(F.lds + GL_KE) + r32 * 136 + 16 * ks + 8 * hi), b1 = *(const LAS bf16x8*)((const LAS bf16*)(F.lds + GL_KE) + (32 + r32) * 136 + 16 * ks + 8 * hi);
            o0 = __builtin_amdgcn_mfma_f32_32x32x16_bf16(a, b0, o0, 0, 0, 0); o1 = __builtin_amdgcn_mfma_f32_32x32x16_bf16(a, b1, o1, 0, 0, 0); } }
    LAS float* SS = (LAS float*)(F.lds + GL_SS);
    { float s0 = 0.f, s1 = 0.f;
#pragma unroll
        for (int r = 0; r < 16; ++r) { s0 += o0[r] * o0[r]; s1 += o1[r] * o1[r]; }
        s0 += __shfl_xor(s0, 32); s1 += __shfl_xor(s1, 32);
        if (hi == 0) { SS[w * 64 + r32] = s0; SS[w * 64 + 32 + r32] = s1; } }
    __syncthreads();
    float rs0 = 0.f, rs1 = 0.f;
#pragma unroll
    for (int ww = 0; ww < 8; ++ww) { rs0 += SS[ww * 64 + r32]; rs1 += SS[ww * 64 + 32 + r32]; }
    rs0 = 1.f / sqrtf(rs0 * (1.f / 256.f) + RMS_EPS); rs1 = 1.f / sqrtf(rs1 * (1.f / 256.f) + RMS_EPS);
    bf16* og = (bf16*)(F.ws + WS_OG) + (size_t)(b * SEQ + 64 * (n - 1)) * 1024 + h * 256 + 32 * w;
    const float* gn = F.in[I_GNORM] + 32 * w;
#pragma unroll
    for (int g = 0; g < 4; ++g) { const int vv = 8 * g + 4 * hi; const f32x4 gg = *(const f32x4*)(gn + vv);
        { u32x2* p = (u32x2*)(og + (size_t)r32 * 1024 + vv); const u32x2 sr = *p; u32x2 o;
            o.x = cvtpk(o0[4 * g] * rs0 * gg[0] * bflo(sr.x), o0[4 * g + 1] * rs0 * gg[1] * bfhi(sr.x)); o.y = cvtpk(o0[4 * g + 2] * rs0 * gg[2] * bflo(sr.y), o0[4 * g + 3] * rs0 * gg[3] * bfhi(sr.y)); *p = o; }
        { u32x2* p = (u32x2*)(og + (size_t)(32 + r32) * 1024 + vv); const u32x2 sr = *p; u32x2 o;
            o.x = cvtpk(o1[4 * g] * rs1 * gg[0] * bflo(sr.x), o1[4 * g + 1] * rs1 * gg[1] * bfhi(sr.x)); o.y = cvtpk(o1[4 * g + 2] * rs1 * gg[2] * bflo(sr.y), o1[4 * g + 3] * rs1 * gg[3] * bfhi(sr.y)); *p = o; } }
    __syncthreads();
}

struct SchedQ {
    const char* A; const char* B; int G, c;
    __device__ __forceinline__ bool next(int i, pg8::Unit& u) const {
        const int L = i * G + c; if (L >= 64 * 6) return false;
        pg8::tile_of(L, 64, 6, u.pm, u.pn); u.aux = 0;
        const int b = u.pm >> 4, j = u.pm & 15; u.a = A + (size_t)(b * LB + 64 + 256 * j) * 384 * 2; u.a2 = u.a; u.b = B + (size_t)u.pn * 256 * 384 * 2; return true;
    }
};
struct EpiQ {
    static constexpr bool PERM = true, HAS_MID = false;
    unsigned char* ws; unsigned char* oa;
    __device__ __forceinline__ void mid(Acc&, const pg8::Unit&, int, int, int, int) const {}
    __device__ __forceinline__ void operator()(Acc& acc, const pg8::Unit& u, int wr, int wc, int fr, int fq) const {
        const int b = u.pm >> 4, j0 = (u.pm & 15) * 256; bf16* Q = (bf16*)(oa + OA_Q); const float* RSQ = (const float*)(ws + SM_RSQ);
#pragma unroll
        for (int ai = 0; ai < 2; ++ai)
#pragma unroll
            for (int m = 0; m < 4; ++m) { const int t = j0 + ai * 128 + wr * 64 + m * 16 + fr; const int rp = b * LB + 64 + t; const float sc = QSCALE2 / sqrtf(RSQ[rp] * (1.f / 384.f) + RMS_EPS);
                bf16* rowp = Q + (size_t)(b * SEQ + t) * 1536 + u.pn * 256 + wc * 32;
#pragma unroll
                for (int bj = 0; bj < 2; ++bj) { const int blk = (u.pn * 256 + bj * 128 + wc * 32) >> 5; f32x4 v0 = acc[ai][bj][m][0] * sc, v1 = acc[ai][bj][m][1] * sc;
                    if (blk % 3 == 2) { const int pos = NMETA + t; const f32x4 cs = *(const f32x4*)((const float*)(ws + SM_COS) + pos * 16 + 4 * fq), sn = *(const f32x4*)((const float*)(ws + SM_SIN) + pos * 16 + 4 * fq);
                        const f32x4 o1 = v0 * cs - v1 * sn, o2 = v0 * sn + v1 * cs; u32x2 w1, w2; w1.x = cvtpk(o1[0], o1[1]); w1.y = cvtpk(o1[2], o1[3]); w2.x = cvtpk(o2[0], o2[1]); w2.y = cvtpk(o2[2], o2[3]);
                        *(u32x2*)(rowp + bj * 128 + 4 * fq) = w1; *(u32x2*)(rowp + bj * 128 + 16 + 4 * fq) = w2; }
                    else store8(rowp + bj * 128 + 8 * fq, v0, v1); } }
    }
};
struct SchedKV {
    const char* A; const char* B; int G, c;
    __device__ __forceinline__ bool next(int i, pg8::Unit& u) const {
        const int L = i * G + c; if (L >= 65 * 8) return false;
        pg8::tile_of(L, 65, 8, u.pm, u.pn); u.aux = 0;
        u.a = A + (size_t)u.pm * 256 * 256 * 2; u.a2 = u.a; u.b = B + (size_t)u.pn * 256 * 256 * 2; return true;
    }
};
struct EpiKV {
    static constexpr bool PERM = true, HAS_MID = false;
    unsigned char* ws;
    __device__ __forceinline__ void mid(Acc&, const pg8::Unit&, int, int, int, int) const {}
    __device__ __forceinline__ void operator()(Acc& acc, const pg8::Unit& u, int wr, int wc, int fr, int fq) const {
        bf16* dst = (bf16*)(ws + (u.pn < 4 ? WS_KN : WS_VV)); const int c0 = (u.pn & 3) * 256; const float* RS = (const float*)(ws + SM_RSKV);
#pragma unroll
        for (int ai = 0; ai < 2; ++ai)
#pragma unroll
            for (int m = 0; m < 4; ++m) { const int rp = u.pm * 256 + ai * 128 + wr * 64 + m * 16 + fr; const float sc = 1.f / sqrtf(RS[rp] * (1.f / 256.f) + RMS_EPS);
                bf16* rowp = dst + (size_t)rp * 1024 + c0 + wc * 32 + 8 * fq;
#pragma unroll
                for (int bj = 0; bj < 2; ++bj) store8(rowp + bj * 128, acc[ai][bj][m][0] * sc, acc[ai][bj][m][1] * sc); }
    }
};

constexpr int AT_K = 0;
constexpr int AT_V = 24576;
constexpr int AT_WS = 40960;
constexpr int AT_OST = 43008;
__device__ __forceinline__ void attn_unit(Frame& F, int b, int h, int jb) {
    const int tid = F.tid, lane = F.lane, wid = F.wave, r32 = lane & 31, hi = lane >> 5;
    const bf16* KN = (const bf16*)(F.ws + WS_KN) + (size_t)b * LB * 1024 + h * 64;
    const bf16* VV = (const bf16*)(F.ws + WS_VV) + (size_t)b * LB * 1024 + h * 64;
    const bf16* KR = (const bf16*)(F.oa + OA_KR) + (size_t)b * LB * 32;
    const bf16* Qw = (const bf16*)(F.oa + OA_Q) + (size_t)(b * SEQ + 256 * jb + 32 * wid) * 1536 + h * 96;
    LAS float* wsf = (LAS float*)(F.lds + AT_WS) + wid * 64;
    const int NT = 4 * jb + 5;
    const int kc = tid >> 6, kk = tid & 63;
    const bf16* ksrc0 = KN + (size_t)kk * 1024 + kc * 8; const bf16* ksrc1 = KR + (size_t)kk * 32 + (kc & 3) * 8;
    const bf16* vsrc = VV + (size_t)(16 * (wid & 3) + (lane >> 2)) * 1024 + (wid >> 2) * 32 + (lane & 3) * 8;
    u32x4 kr0, kr1 = {0, 0, 0, 0}, vr;
    kr0 = *(const u32x4*)ksrc0; if (tid < 256) kr1 = *(const u32x4*)ksrc1; vr = *(const u32x4*)vsrc;
    bf16x8 qr[6];
#pragma unroll
    for (int d0 = 0; d0 < 6; ++d0) qr[d0] = *(const bf16x8*)(Qw + (size_t)r32 * 1536 + d0 * 16 + hi * 8);
    *(LAS u32x4*)(F.lds + AT_K + kc * 1024 + kk * 16) = kr0; if (tid < 256) *(LAS u32x4*)(F.lds + AT_K + (8 + kc) * 1024 + kk * 16) = kr1; *(LAS u32x4*)(F.lds + AT_V + tid * 16) = vr;
    __syncthreads();
    float mrun = -1e30f, lrun = 0.f; f32x16 o[2]; o[0] = f32x16{}; o[1] = f32x16{};
    const int qrel = 64 + 256 * jb + 32 * wid + r32;
    for (int t = 0; t < NT; ++t) {
        const int buf = t & 1; const bool more = (t + 1 < NT);
        if (more) { const size_t ro = (size_t)(t + 1) * 64; kr0 = *(const u32x4*)(ksrc0 + ro * 1024); if (tid < 256) kr1 = *(const u32x4*)(ksrc1 + ro * 32); vr = *(const u32x4*)(vsrc + ro * 1024); }
        f32x16 p0 = {}, p1 = {};
        { const LAS unsigned char* kb = F.lds + AT_K + buf * 12288 + hi * 1024 + r32 * 16;
#pragma unroll
            for (int d0 = 0; d0 < 6; ++d0) { const bf16x8 b0 = *(const LAS bf16x8*)(kb + d0 * 2048), b1 = *(const LAS bf16x8*)(kb + d0 * 2048 + 512);
                p0 = __builtin_amdgcn_mfma_f32_32x32x16_bf16(b0, qr[d0], p0, 0, 0, 0); p1 = __builtin_amdgcn_mfma_f32_32x32x16_bf16(b1, qr[d0], p1, 0, 0, 0); } }
        if (t == 0 || t >= NT - 4) {
#pragma unroll
            for (int r = 0; r < 16; ++r) { const int k0 = 64 * t + crow(r, hi), k1 = k0 + 32;
                if (k0 > qrel || k0 < 48) p0[r] = -INFINITY; if (k1 > qrel || k1 < 48) p1[r] = -INFINITY; } }
        float mx = fmaxf(p0[0], p1[0]);
#pragma unroll
        for (int r = 1; r < 16; ++r) mx = fmaxf(mx, fmaxf(p0[r], p1[r]));
        mx = fmaxf(mx, __shfl_xor(mx, 32));
        const float mnew = fmaxf(mrun, mx); const float alpha = __builtin_amdgcn_exp2f(mrun - mnew); mrun = mnew;
        float rsum = 0.f;
#pragma unroll
        for (int r = 0; r < 16; ++r) { p0[r] = __builtin_amdgcn_exp2f(p0[r] - mnew); p1[r] = __builtin_amdgcn_exp2f(p1[r] - mnew); rsum += p0[r] + p1[r]; }
        lrun = lrun * alpha + rsum;
        if (__any(alpha != 1.f)) { if (hi == 0) wsf[r32] = alpha; LDS_WAIT();
#pragma unroll
            for (int r = 0; r < 16; ++r) { const float f = wsf[crow(r, hi)]; o[0][r] *= f; o[1][r] *= f; } }
        u32x4 pw[4];
#pragma unroll
        for (int k = 0; k < 2; ++k) { pw[k] = (u32x4){cvtpk(p0[8 * k], p0[8 * k + 1]), cvtpk(p0[8 * k + 2], p0[8 * k + 3]), cvtpk(p0[8 * k + 4], p0[8 * k + 5]), cvtpk(p0[8 * k + 6], p0[8 * k + 7])};
            pw[2 + k] = (u32x4){cvtpk(p1[8 * k], p1[8 * k + 1]), cvtpk(p1[8 * k + 2], p1[8 * k + 3]), cvtpk(p1[8 * k + 4], p1[8 * k + 5]), cvtpk(p1[8 * k + 6], p1[8 * k + 7])}; }
        { const LAS unsigned char* vb = F.lds + AT_V + buf * 8192 + ((lane >> 4) & 1) * 32 + (lane & 3) * 8 + (4 * hi + ((lane & 15) >> 2)) * 64;
#pragma unroll
            for (int d0 = 0; d0 < 2; ++d0)
#pragma unroll
                for (int ks = 0; ks < 4; ++ks) { const s16x4 lo = tr16(vb + d0 * 4096 + ks * 1024), h4 = tr16(vb + d0 * 4096 + ks * 1024 + 512);
                    const bf16x8 vf = (bf16x8){lo[0], lo[1], lo[2], lo[3], h4[0], h4[1], h4[2], h4[3]};
                    o[d0] = __builtin_amdgcn_mfma_f32_32x32x16_bf16(__builtin_bit_cast(bf16x8, pw[ks]), vf, o[d0], 0, 0, 0); } }
        if (more) { const int nb = buf ^ 1; *(LAS u32x4*)(F.lds + AT_K + nb * 12288 + kc * 1024 + kk * 16) = kr0; if (tid < 256) *(LAS u32x4*)(F.lds + AT_K + nb * 12288 + (8 + kc) * 1024 + kk * 16) = kr1;
            *(LAS u32x4*)(F.lds + AT_V + nb * 8192 + tid * 16) = vr; }
        __syncthreads();
    }
    lrun += __shfl_xor(lrun, 32);
    if (hi == 0) wsf[32 + r32] = 1.f / lrun; LDS_WAIT();
    bf16* Ow = (bf16*)(F.ws + WS_OM) + (size_t)(b * SEQ + 256 * jb + 32 * wid) * 1024 + h * 64;
    { LAS bf16* stg = (LAS bf16*)(F.lds + AT_OST) + wid * 2048;
#pragma unroll
        for (int r = 0; r < 16; ++r) { const int orow = crow(r, hi); const float f = wsf[32 + orow];
#pragma unroll
            for (int d0 = 0; d0 < 2; ++d0) stg[orow * 64 + d0 * 32 + r32] = f2bf(o[d0][r] * f); }
        LDS_WAIT();
#pragma unroll
        for (int i = 0; i < 4; ++i) { const int row = i * 8 + (lane >> 3), ch = lane & 7; *(u32x4*)(Ow + (size_t)row * 1024 + ch * 8) = *(const LAS u32x4*)(stg + row * 64 + ch * 8); } }
    __syncthreads();
}

struct SchedP4 {
    const char* A0; const char* A1; const char* B; int G, c;
    __device__ __forceinline__ bool next(int i, pg8::Unit& u) const {
        const int L = i * G + c; if (L >= 64 * 4) return false;
        pg8::tile_of(L, 64, 4, u.pm, u.pn); u.aux = 0;
        u.a = A0 + (size_t)u.pm * 256 * 1024 * 2; u.a2 = A1 + (size_t)u.pm * 256 * 1024 * 2; u.b = B + (size_t)u.pn * 256 * 2048 * 2; return true;
    }
};
struct EpiP4 {
    static constexpr bool PERM = true, HAS_MID = true;
    unsigned char* ws;
    __device__ __forceinline__ void mid(Acc& acc, const pg8::Unit& u, int wr, int wc, int fr, int fq) const {
        const bf16* GA = (const bf16*)(ws + WS_GA); const bf16* GB = (const bf16*)(ws + WS_GB);
#pragma unroll
        for (int ai = 0; ai < 2; ++ai)
#pragma unroll
            for (int m = 0; m < 4; ++m) { const size_t off = (size_t)(u.pm * 256 + ai * 128 + wr * 64 + m * 16 + fr) * 1024 + u.pn * 256 + wc * 32 + 8 * fq;
#pragma unroll
                for (int bj = 0; bj < 2; ++bj) { const u32x4 a = *(const u32x4*)(GA + off + bj * 128), g = *(const u32x4*)(GB + off + bj * 128);
                    acc[ai][bj][m][0][0] *= bflo(a.x) * __builtin_amdgcn_rcpf(bflo(g.x)); acc[ai][bj][m][0][1] *= bfhi(a.x) * __builtin_amdgcn_rcpf(bfhi(g.x)); acc[ai][bj][m][0][2] *= bflo(a.y) * __builtin_amdgcn_rcpf(bflo(g.y)); acc[ai][bj][m][0][3] *= bfhi(a.y) * __builtin_amdgcn_rcpf(bfhi(g.y));
                    acc[ai][bj][m][1][0] *= bflo(a.z) * __builtin_amdgcn_rcpf(bflo(g.z)); acc[ai][bj][m][1][1] *= bfhi(a.z) * __builtin_amdgcn_rcpf(bfhi(g.z)); acc[ai][bj][m][1][2] *= bflo(a.w) * __builtin_amdgcn_rcpf(bflo(g.w)); acc[ai][bj][m][1][3] *= bfhi(a.w) * __builtin_amdgcn_rcpf(bfhi(g.w)); }
                asm volatile("" ::: "memory"); }
    }
    __device__ __forceinline__ void operator()(Acc& acc, const pg8::Unit& u, int wr, int wc, int fr, int fq) const {
        const bf16* GB = (const bf16*)(ws + WS_GB); bf16* MG = (bf16*)(ws + WS_MERGED);
#pragma unroll
        for (int ai = 0; ai < 2; ++ai)
#pragma unroll
            for (int m = 0; m < 4; ++m) { const size_t off = (size_t)(u.pm * 256 + ai * 128 + wr * 64 + m * 16 + fr) * 1024 + u.pn * 256 + wc * 32 + 8 * fq;
#pragma unroll
                for (int bj = 0; bj < 2; ++bj) { const u32x4 g = *(const u32x4*)(GB + off + bj * 128); f32x4 v0 = acc[ai][bj][m][0], v1 = acc[ai][bj][m][1];
                    v0[0] *= bflo(g.x); v0[1] *= bfhi(g.x); v0[2] *= bflo(g.y); v0[3] *= bfhi(g.y); v1[0] *= bflo(g.z); v1[1] *= bfhi(g.z); v1[2] *= bflo(g.w); v1[3] *= bfhi(g.w);
                    store8(MG + off + bj * 128, v0, v1); }
                asm volatile("" ::: "memory"); }
    }
};
struct SchedP5 {
    const char* A; const char* B; int G, c;
    __device__ __forceinline__ bool next(int i, pg8::Unit& u) const {
        const int L = i * G + c; if (L >= 64 * 4) return false;
        pg8::tile_of(L, 64, 4, u.pm, u.pn); u.aux = 0;
        u.a = A + (size_t)u.pm * 256 * 1024 * 2; u.a2 = u.a; u.b = B + (size_t)u.pn * 256 * 1024 * 2; return true;
    }
};
struct EpiP5 {
    static constexpr bool PERM = true, HAS_MID = false;
    unsigned char* ws; float* y1;
    __device__ __forceinline__ void mid(Acc&, const pg8::Unit&, int, int, int, int) const {}
    __device__ __forceinline__ void operator()(Acc& acc, const pg8::Unit& u, int wr, int wc, int fr, int fq) const {
        const bf16* S0 = (const bf16*)(ws + WS_S0); const int b = u.pm >> 4, j0 = (u.pm & 15) * 256;
#pragma unroll
        for (int ai = 0; ai < 2; ++ai)
#pragma unroll
            for (int m = 0; m < 4; ++m) { const int t = j0 + ai * 128 + wr * 64 + m * 16 + fr; const int col = u.pn * 256 + wc * 32 + 8 * fq;
                const bf16* sp = S0 + (size_t)(b * LB + 64 + t) * 1024 + col; float* yp = y1 + (size_t)(b * SEQ + t) * 1024 + col;
#pragma unroll
                for (int bj = 0; bj < 2; ++bj) { const u32x4 s = *(const u32x4*)(sp + bj * 128); f32x4 v0 = acc[ai][bj][m][0], v1 = acc[ai][bj][m][1];
                    v0[0] += ALPHA * bflo(s.x); v0[1] += ALPHA * bfhi(s.x); v0[2] += ALPHA * bflo(s.y); v0[3] += ALPHA * bfhi(s.y); v1[0] += ALPHA * bflo(s.z); v1[1] += ALPHA * bfhi(s.z); v1[2] += ALPHA * bflo(s.w); v1[3] += ALPHA * bfhi(s.w);
                    *(f32x4*)(yp + bj * 128) = v0; *(f32x4*)(yp + bj * 128 + 4) = v1; }
                asm volatile("" ::: "memory"); }
    }
};

struct Route { int e0, e1; float c0, c1; };
__device__ __forceinline__ void p6a(Frame& F, float* y1) {
    LAS int* hist = (LAS int*)(F.lds + 131072 - 256);
    if (F.tid < 32) hist[F.tid] = 0;
    __syncthreads();
    const int lane = F.lane; const int blk = F.vcu;
    Route* RT = (Route*)(F.ws + SM_ROUTE); bf16* S1B = (bf16*)(F.ws + WS_S1B);
    const float* g = F.in[I_LNM_G]; const float* bt = F.in[I_LNM_B];
    for (int i = 0; i < 8; ++i) {
        const int rc = 64 * blk + 8 * F.wave + i; float* yr = y1 + (size_t)rc * D;
        f32x4 v[4]; float s = 0.f;
#pragma unroll
        for (int j = 0; j < 4; ++j) { v[j] = ((const f32x4*)yr)[lane + 64 * j]; s += (v[j].x + v[j].y) + (v[j].z + v[j].w); }
        const float mean = wave_sum(s) * (1.f / D); float s2 = 0.f;
#pragma unroll
        for (int j = 0; j < 4; ++j) { v[j] = v[j] - mean; s2 += (v[j].x * v[j].x + v[j].y * v[j].y) + (v[j].z * v[j].z + v[j].w * v[j].w); }
        const float rstd = 1.f / sqrtf(wave_sum(s2) * (1.f / D) + LN_EPS);
        float gl[4] = {0.f, 0.f, 0.f, 0.f};
#pragma unroll
        for (int j = 0; j < 4; ++j) { const f32x4 gg = ((const f32x4*)g)[lane + 64 * j], bb = ((const f32x4*)bt)[lane + 64 * j]; v[j] = v[j] * rstd * gg + bb;
            ((f32x4*)yr)[lane + 64 * j] = v[j]; u32x2 w; w.x = cvtpk(v[j].x, v[j].y); w.y = cvtpk(v[j].z, v[j].w); ((u32x2*)(S1B + (size_t)rc * D))[lane + 64 * j] = w;
            const int k0 = 4 * lane + 256 * j;
#pragma unroll
            for (int e = 0; e < 4; ++e) { const f32x4 wg = *(const f32x4*)(F.in[I_RGW] + (size_t)(k0 + e) * 4); const float x = v[j][e]; gl[0] += x * wg[0]; gl[1] += x * wg[1]; gl[2] += x * wg[2]; gl[3] += x * wg[3]; } }
#pragma unroll
        for (int q = 0; q < 4; ++q) gl[q] = wave_sum(gl[q]) + F.in[I_RGB][q];
        int gi = 0; float gm = gl[0];
#pragma unroll
        for (int q = 1; q < 4; ++q) if (gl[q] > gm) { gm = gl[q]; gi = q; }
        float den = 0.f;
#pragma unroll
        for (int q = 0; q < 4; ++q) den += __expf(gl[q] - gm);
        const float pg = 1.f / den;
        float el[8] = {0.f, 0.f, 0.f, 0.f, 0.f, 0.f, 0.f, 0.f};
#pragma unroll
        for (int j = 0; j < 4; ++j) { const int k0 = 4 * lane + 256 * j;
#pragma unroll
            for (int e = 0; e < 4; ++e) { const float* wp = F.in[I_REW] + (size_t)(k0 + e) * 32 + gi * 8; const f32x4 wa = *(const f32x4*)wp, wb = *(const f32x4*)(wp + 4); const float x = v[j][e];
                el[0] += x * wa[0]; el[1] += x * wa[1]; el[2] += x * wa[2]; el[3] += x * wa[3]; el[4] += x * wb[0]; el[5] += x * wb[1]; el[6] += x * wb[2]; el[7] += x * wb[3]; } }
#pragma unroll
        for (int q = 0; q < 8; ++q) el[q] = wave_sum(el[q]) + F.in[I_REB][gi * 8 + q];
        int i0 = 0; float v0 = el[0];
#pragma unroll
        for (int q = 1; q < 8; ++q) if (el[q] > v0) { v0 = el[q]; i0 = q; }
        int i1 = -1; float v1 = -INFINITY;
#pragma unroll
        for (int q = 0; q < 8; ++q) if (q != i0 && el[q] > v1) { v1 = el[q]; i1 = q; }
        const float e1 = __expf(v1 - v0), p0 = 1.f / (1.f + e1), p1 = e1 / (1.f + e1);
        if (lane == 0) { Route r; r.e0 = gi * 8 + i0; r.e1 = gi * 8 + i1; r.c0 = pg * p0; r.c1 = pg * p1; RT[rc] = r; __hip_atomic_fetch_add(&hist[r.e0], 1, __ATOMIC_RELAXED, __HIP_MEMORY_SCOPE_WORKGROUP); __hip_atomic_fetch_add(&hist[r.e1], 1, __ATOMIC_RELAXED, __HIP_MEMORY_SCOPE_WORKGROUP); }
    }
    __syncthreads();
    if (F.tid < 32) ((int*)(F.ws + SM_HIST))[blk * 32 + F.tid] = hist[F.tid];
    LAS float* scr = (LAS float*)(F.lds + F.wave * 16384);
    const int gw = F.vcu * NWAVES + F.wave, NGW = F.G * NWAVES;
    constexpr int IG = (1024 / 64) * (512 / 32), IDN = (256 / 64) * (1024 / 32);
    for (int it = gw; it < NEXP * (IG + IDN); it += NGW) {
        const int e = it / (IG + IDN), r = it % (IG + IDN); TSrc s;
        if (r < IG) { s = TSrc{F.in[I_EWG] + (size_t)e * 1024 * 256, F.in[I_EWU] + (size_t)e * 1024 * 256, nullptr, 5}; transpose_item(s, 1024, 512, (bf16*)(F.ws + WS_WGU) + (size_t)e * 512 * 1024, scr, r, F.lane); }
        else { s = TSrc{F.in[I_EWD] + (size_t)e * 256 * 1024, nullptr, nullptr, 6}; transpose_item(s, 256, 1024, (bf16*)(F.ws + WS_WD) + (size_t)e * 1024 * 256, scr, r - IG, F.lane); }
    }
}
__device__ __forceinline__ void p6b(Frame& F) {
    LAS int* cur = (LAS int*)(F.lds + 1024);
    LAS int* cnt = (LAS int*)(F.lds + 1280);
    LAS int* bas = (LAS int*)(F.lds + 1536);
    const int blk = F.vcu; const int* HIST = (const int*)(F.ws + SM_HIST);
    if (F.tid < 32) { int tot = 0, off = 0; for (int bb = 0; bb < 256; ++bb) { const int c = HIST[bb * 32 + F.tid]; if (bb < blk) off += c; tot += c; } cnt[F.tid] = tot; cur[F.tid] = off; }
    __syncthreads();
    if (F.tid == 0) { int acc = 0; for (int e = 0; e < 32; ++e) { bas[e] = acc; acc += ((cnt[e] + 255) >> 8) << 8; } bas[32] = acc;
        if (blk == 0) { int* TE = (int*)(F.ws + SM_TILE); int nt = 0; for (int e = 0; e < 32; ++e) for (int k = 0; k < ((cnt[e] + 255) >> 8); ++k) TE[1 + nt++] = e; TE[0] = nt; } }
    __syncthreads();
    const Route* RT = (const Route*)(F.ws + SM_ROUTE); const bf16* S1B = (const bf16*)(F.ws + WS_S1B); bf16* XS = (bf16*)(F.ws + WS_XS);
    int* SLOT = (int*)(F.ws + SM_SLOT); float* CW = (float*)(F.ws + SM_CW);
    for (int i = 0; i < 8; ++i) {
        const int rc = 64 * blk + 8 * F.wave + i; const Route r = RT[rc]; int s0 = 0, s1 = 0;
        if (F.lane == 0) { s0 = bas[r.e0] + __hip_atomic_fetch_add(&cur[r.e0], 1, __ATOMIC_RELAXED, __HIP_MEMORY_SCOPE_WORKGROUP); s1 = bas[r.e1] + __hip_atomic_fetch_add(&cur[r.e1], 1, __ATOMIC_RELAXED, __HIP_MEMORY_SCOPE_WORKGROUP); SLOT[2 * rc] = s0; SLOT[2 * rc + 1] = s1; CW[s0] = r.c0; CW[s1] = r.c1; }
        s0 = __builtin_amdgcn_readfirstlane(s0); s1 = __builtin_amdgcn_readfirstlane(s1);
        const u32x4* src = (const u32x4*)(S1B + (size_t)rc * D) + F.lane; const u32x4 a = src[0], c = src[64];
        u32x4* d0 = (u32x4*)(XS + (size_t)s0 * D) + F.lane; u32x4* d1 = (u32x4*)(XS + (size_t)s1 * D) + F.lane; d0[0] = a; d0[64] = c; d1[0] = a; d1[64] = c;
    }
    if (blk < 32) { const int c = cnt[blk], hi = ((c + 255) >> 8) << 8;
        for (int r = c + F.wave; r < hi; r += NWAVES) { u32x4* d0 = (u32x4*)(XS + (size_t)(bas[blk] + r) * D) + F.lane; d0[0] = (u32x4){0, 0, 0, 0}; d0[64] = (u32x4){0, 0, 0, 0}; if (F.lane == 0) CW[bas[blk] + r] = 0.f; } }
}

struct SchedP7 {
    const char* A; const char* B; const int* TE; int G, c;
    __device__ __forceinline__ bool next(int i, pg8::Unit& u) const {
        const int nt = TE[0]; const int L = i * G + c; if (L >= nt * 2) return false;
        u.pm = L >> 1; u.pn = L & 1; const int e = TE[1 + u.pm]; u.aux = e;
        u.a = A + (size_t)u.pm * 256 * 1024 * 2; u.a2 = u.a; u.b = B + ((size_t)e * 512 + u.pn * 256) * 1024 * 2; return true;
    }
};
struct EpiP7 {
    static constexpr bool PERM = true, HAS_MID = false;
    unsigned char* ws;
    __device__ __forceinline__ void mid(Acc&, const pg8::Unit&, int, int, int, int) const {}
    __device__ __forceinline__ void operator()(Acc& acc, const pg8::Unit& u, int wr, int wc, int fr, int fq) const {
        bf16* HID = (bf16*)(ws + WS_HID); const float* CW = (const float*)(ws + SM_CW);
#pragma unroll
        for (int ai = 0; ai < 2; ++ai)
#pragma unroll
            for (int m = 0; m < 4; ++m) { const int row = u.pm * 256 + ai * 128 + wr * 64 + m * 16 + fr; const float cw = CW[row];
                f32x4 v0, v1;
#pragma unroll
                for (int e = 0; e < 4; ++e) { const float a0 = acc[ai][0][m][0][e], a1 = acc[ai][0][m][1][e]; v0[e] = a0 * sigmoidf_(a0) * acc[ai][1][m][0][e] * cw; v1[e] = a1 * sigmoidf_(a1) * acc[ai][1][m][1][e] * cw; }
                store8(HID + (size_t)row * 256 + u.pn * 128 + wc * 32 + 8 * fq, v0, v1); }
    }
};
struct SchedP8 {
    const char* A; const char* B; const int* TE; int G, c;
    __device__ __forceinline__ bool next(int i, pg8::Unit& u) const {
        const int nt = TE[0]; const int L = i * G + c; if (L >= nt * 4) return false;
        u.pm = L >> 2; u.pn = L & 3; const int e = TE[1 + u.pm]; u.aux = e;
        u.a = A + (size_t)u.pm * 256 * 256 * 2; u.a2 = u.a; u.b = B + ((size_t)e * 1024 + u.pn * 256) * 256 * 2; return true;
    }
};
struct EpiP8 {
    static constexpr bool PERM = true, HAS_MID = false;
    unsigned char* ws;
    __device__ __forceinline__ void mid(Acc&, const pg8::Unit&, int, int, int, int) const {}
    __device__ __forceinline__ void operator()(Acc& acc, const pg8::Unit& u, int wr, int wc, int fr, int fq) const {
        bf16* YS = (bf16*)(ws + WS_YS);
#pragma unroll
        for (int ai = 0; ai < 2; ++ai)
#pragma unroll
            for (int m = 0; m < 4; ++m) { bf16* rowp = YS + (size_t)(u.pm * 256 + ai * 128 + wr * 64 + m * 16 + fr) * 1024 + u.pn * 256 + wc * 32 + 8 * fq;
#pragma unroll
                for (int bj = 0; bj < 2; ++bj) store8(rowp + bj * 128, acc[ai][bj][m][0], acc[ai][bj][m][1]); }
    }
};
__device__ __forceinline__ void p9(Frame& F, float* out) {
    const int gw = F.vcu * NWAVES + F.wave, NGW = F.G * NWAVES, lane = F.lane;
    const int* SLOT = (const int*)(F.ws + SM_SLOT); const bf16* YS = (const bf16*)(F.ws + WS_YS);
    const float* g = F.in[I_LNF_G]; const float* bt = F.in[I_LNF_B];
    for (int rc = gw; rc < RC; rc += NGW) {
        const int s0 = SLOT[2 * rc], s1 = SLOT[2 * rc + 1]; float* yr = out + (size_t)rc * D;
        f32x4 v[4]; float s = 0.f;
#pragma unroll
        for (int j = 0; j < 4; ++j) { const f32x4 x = ((const f32x4*)yr)[lane + 64 * j]; const u32x2 a = ((const u32x2*)(YS + (size_t)s0 * D))[lane + 64 * j], c = ((const u32x2*)(YS + (size_t)s1 * D))[lane + 64 * j];
            v[j].x = ALPHA * x.x + (bflo(a.x) + bflo(c.x)); v[j].y = ALPHA * x.y + (bfhi(a.x) + bfhi(c.x)); v[j].z = ALPHA * x.z + (bflo(a.y) + bflo(c.y)); v[j].w = ALPHA * x.w + (bfhi(a.y) + bfhi(c.y));
            s += (v[j].x + v[j].y) + (v[j].z + v[j].w); }
        const float mean = wave_sum(s) * (1.f / D); float s2 = 0.f;
#pragma unroll
        for (int j = 0; j < 4; ++j) { v[j] = v[j] - mean; s2 += (v[j].x * v[j].x + v[j].y * v[j].y) + (v[j].z * v[j].z + v[j].w * v[j].w); }
        const float rstd = 1.f / sqrtf(wave_sum(s2) * (1.f / D) + LN_EPS);
#pragma unroll
        for (int j = 0; j < 4; ++j) { const f32x4 gg = ((const f32x4*)g)[lane + 64 * j], bb = ((const f32x4*)bt)[lane + 64 * j]; ((f32x4*)yr)[lane + 64 * j] = v[j] * rstd * gg + bb; }
    }
}

constexpr int NPHASE = 14;
__global__ void __launch_bounds__(NWAVES * 64, 2) fwd_kernel(Args args) {
    extern __shared__ __attribute__((aligned(16))) unsigned char lds_raw[];
    Frame F;
    F.lds = (LAS unsigned char*)lds_raw; F.ldsg = (char*)lds_raw;
    F.tid = threadIdx.x; F.lane = F.tid & 63; F.wave = __builtin_amdgcn_readfirstlane(F.tid >> 6);
    F.G = gridDim.x; { const int bx = blockIdx.x; F.vcu = (F.G % 8 == 0) ? (bx % 8) * (F.G / 8) + bx / 8 : bx; }
    F.ws = args.ws; F.oa = (unsigned char*)args.out; F.in = args.in;
    volatile LAS unsigned* MISC = (volatile LAS unsigned*)(F.lds + MISC_OFF);
    if (F.tid < 32) MISC[F.tid] = 0u;
    __syncthreads();
    const int lo = args.ph_lo, hi = args.ph_hi;
    const bool multi = (hi - lo) > 1;
    XcdBarrier bar; bar.bar = (unsigned*)(F.ws + WS_CTL) + 1024; bar.x = 0; bar.st = nullptr;
    if (multi) bar = xcd_barrier_post((unsigned*)(F.ws + WS_CTL) + 1024, MISC + 8);
#ifndef PHASE_MASK
#define PHASE_MASK 0x3fff
#endif
#define IN(k) (((PHASE_MASK >> (k)) & 1) && lo <= (k) && (k) < hi)
#define SEAM(k) do { if (IN(k) && IN((k) + 1)) xcd_barrier(bar); } while (0)
    const int c = (int)blockIdx.x;

    if (IN(0)) { p0_prologue(F); } SEAM(0);
    if (IN(1)) { SchedP1 S{(const char*)(F.ws + WS_S0), (const char*)(F.ws + WS_WIN), F.G, c}; EpiP1 E{F.ws, F.oa};
        pg8::gemm_phase<EpiP1, SchedP1, true>(F.lds, 1024, 1024, 1024, 16, S, E); } SEAM(1);
    if (IN(2)) { for (int u = F.vcu; u < 16 * NCH; u += F.G) { const int bh = u / NCH, n = u % NCH; gla_g1_unit(F, bh >> 2, bh & 3, n); } } SEAM(2);
    if (IN(3)) { gla_g2(F); } SEAM(3);
    if (IN(4)) { for (int u = F.vcu; u < 16 * 64; u += F.G) { const int bh = u >> 6, n = 1 + (u & 63); gla_g3_unit(F, bh >> 2, bh & 3, n); } } SEAM(4);
    if (IN(5)) {
        { SchedQ S{(const char*)(F.ws + WS_CQ), (const char*)(F.ws + WS_WUQ), F.G, c}; EpiQ E{F.ws, F.oa}; pg8::gemm_phase<EpiQ, SchedQ, true>(F.lds, 384, 384, 384, 6, S, E); }
        { SchedKV S{(const char*)(F.oa + OA_CKV), (const char*)(F.ws + WS_WUKV), F.G, c}; EpiKV E{F.ws}; pg8::gemm_phase<EpiKV, SchedKV, true>(F.lds, 256, 256, 256, 4, S, E); }
    } SEAM(5);
    if (IN(6)) { const int bh = F.vcu >> 2, s = F.vcu & 3;
        if (F.G == 256) { for (int i = 0; i < 4; ++i) { const int jb = (i == 0) ? s : (i == 1) ? 7 - s : (i == 2) ? 8 + s : 15 - s; attn_unit(F, bh >> 4, bh & 15, jb); } }
    } SEAM(6);
    if (IN(7)) { SchedP4 S{(const char*)(F.ws + WS_OG), (const char*)(F.ws + WS_OM), (const char*)(F.ws + WS_WBR), F.G, c}; EpiP4 E{F.ws};
        pg8::gemm_phase<EpiP4, SchedP4, true>(F.lds, 1024, 2048, 2048, 16, S, E); } SEAM(7);
    if (IN(8)) { SchedP5 S{(const char*)(F.ws + WS_MERGED), (const char*)(F.ws + WS_WOUT), F.G, c}; EpiP5 E{F.ws, args.out};
        pg8::gemm_phase<EpiP5, SchedP5, true>(F.lds, 1024, 1024, 1024, 16, S, E); } SEAM(8);
    if (IN(9)) { p6a(F, args.out); } SEAM(9);
    if (IN(10)) { p6b(F); } SEAM(10);
    if (IN(11)) { SchedP7 S{(const char*)(F.ws + WS_XS), (const char*)(F.ws + WS_WGU), (const int*)(F.ws + SM_TILE), F.G, c}; EpiP7 E{F.ws};
        pg8::gemm_phase<EpiP7, SchedP7, true>(F.lds, 1024, 1024, 1024, 16, S, E); } SEAM(11);
    if (IN(12)) { SchedP8 S{(const char*)(F.ws + WS_HID), (const char*)(F.ws + WS_WD), (const int*)(F.ws + SM_TILE), F.G, c}; EpiP8 E{F.ws};
        pg8::gemm_phase<EpiP8, SchedP8, true>(F.lds, 256, 256, 256, 4, S, E); } SEAM(12);
    if (IN(13)) { p9(F, args.out); }
#undef IN
#undef SEAM
}

#ifndef N_LAUNCHES
#define N_LAUNCHES 1
#endif
extern "C" void kernel_launch(void* const* d_in, const int* in_sizes, int n_in, void* d_out, int out_size, void* d_ws, size_t ws_size, hipStream_t stream) {
    static int grid = 0;
    if (grid == 0) {
        if (n_in != 27 || out_size != RC * D || ws_size < 256 * MiB) { fprintf(stderr, "kernel_launch: unexpected shapes (n_in %d out %d ws %zu)\n", n_in, out_size, ws_size); grid = -1; return; }
        int dev = 0, cus = 0, per_cu = 0;
        hipGetDevice(&dev); hipDeviceGetAttribute(&cus, hipDeviceAttributeMultiprocessorCount, dev);
        if (hipFuncSetAttribute((const void*)fwd_kernel, hipFuncAttributeMaxDynamicSharedMemorySize, LDS_BYTES) != hipSuccess) { fprintf(stderr, "kernel_launch: hipFuncSetAttribute failed\n"); grid = -1; return; }
        hipOccupancyMaxActiveBlocksPerMultiprocessor(&per_cu, (const void*)fwd_kernel, NWAVES * 64, LDS_BYTES);
        (void)hipGetLastError();
        if (per_cu < 1 || cus < 256) { fprintf(stderr, "kernel_launch: occupancy %d blocks/CU on %d CUs: need one resident workgroup on each of 256 CUs\n", per_cu, cus); grid = -1; return; }
        grid = 256;
    }
    if (grid < 0) return;
    hipMemsetAsync((char*)d_ws + WS_CTL, 0, CTL_ZERO_BYTES, stream);
    Args a{};
    for (int i = 0; i < 27; ++i) a.in[i] = (const float*)d_in[i];
    a.out = (float*)d_out; a.ws = (unsigned char*)d_ws;
#if N_LAUNCHES == 1
    a.ph_lo = 0; a.ph_hi = NPHASE;
    hipLaunchKernelGGL(fwd_kernel, dim3(grid), dim3(NWAVES * 64), LDS_BYTES, stream, a);
#else
    for (int p = 0; p < NPHASE; ++p) { a.ph_lo = p; a.ph_hi = p + 1; hipLaunchKernelGGL(fwd_kernel, dim3(grid), dim3(NWAVES * 64), LDS_BYTES, stream, a); }
#endif
}
```
